# Optimizing an MI355X kernel written in HIP

```python
import jax, jax.numpy as jnp
from jax import lax
import numpy as np

D_MODEL = 2048
BATCH = 8
SEQ = 4096
DEPTH = 2

CHUNK = 64
N_HEADS = 16
HEAD_DIM = D_MODEL // N_HEADS
D_FF = 4 * D_MODEL
Q_BLOCK = 128
N_PREV_CHUNKS = 8
REL_CLIP = 256
N_REL = REL_CLIP + CHUNK
N_A = DEPTH // 2
N_B = DEPTH - N_A
EPS = 1e-6
FGATE_BIAS = 3.0

kernel_name = "fox_yoco_chunked_relbias_hybrid"


def rms_norm(x, g):
    xf = x.astype(jnp.float32)
    y = xf * lax.rsqrt(jnp.mean(xf * xf, axis=-1, keepdims=True) + EPS)
    return (y * g.astype(jnp.float32)).astype(x.dtype)


def sq_relu_mlp(h, g, w1, w2):
    a = jax.nn.relu(rms_norm(h, g) @ w1)
    return (a * a) @ w2


def forgetting_attention(q, k, v, logf):
    S = q.shape[1]
    scale = HEAD_DIM ** -0.5
    c = jnp.transpose(jnp.cumsum(logf, axis=1), (0, 2, 1))
    outs = []
    for i in range(S // Q_BLOCK):
        q0, q1 = i * Q_BLOCK, (i + 1) * Q_BLOCK
        qb = q[:, q0:q1]
        kb, vb = k[:, :q1], v[:, :q1]
        s = jnp.einsum('bqhd,bkhd->bhqk', qb, kb).astype(jnp.float32) * scale
        s = s + c[:, :, q0:q1, None] - c[:, :, None, :q1]
        causal = (q0 + jnp.arange(Q_BLOCK))[:, None] >= jnp.arange(q1)[None, :]
        s = jnp.where(causal[None, None], s, -jnp.inf)
        p = jax.nn.softmax(s, axis=-1).astype(vb.dtype)
        outs.append(jnp.einsum('bhqk,bkhd->bqhd', p, vb))
    return jnp.concatenate(outs, axis=1)


def chunked_relbias_attention(q, k, v, rel_table):
    B, S, H, Dh = q.shape
    n_chunks = S // CHUNK
    pad = N_PREV_CHUNKS * CHUNK
    band = pad + CHUNK
    scale = HEAD_DIM ** -0.5
    kp = jnp.pad(k, ((0, 0), (pad, 0), (0, 0), (0, 0)))
    vp = jnp.pad(v, ((0, 0), (pad, 0), (0, 0), (0, 0)))
    qi = jnp.arange(CHUNK)[:, None]
    km = jnp.arange(band)[None, :]
    dist = pad + qi - km
    idx = jnp.clip(dist, -(CHUNK - 1), REL_CLIP) + (CHUNK - 1)
    bias = rel_table[:, idx].astype(jnp.float32)
    qc = q.reshape(B, n_chunks, CHUNK, H, Dh)

    def one_chunk(ci):
        qb = lax.dynamic_index_in_dim(qc, ci, axis=1, keepdims=False)
        kb = lax.dynamic_slice_in_dim(kp, ci * CHUNK, band, axis=1)
        vb = lax.dynamic_slice_in_dim(vp, ci * CHUNK, band, axis=1)
        s = jnp.einsum('bqhd,bkhd->bhqk', qb, kb).astype(jnp.float32) * scale + bias[None]
        valid = km >= pad - ci * CHUNK
        s = jnp.where(valid[None, None], s, -jnp.inf)
        p = jax.nn.softmax(s, axis=-1).astype(vb.dtype)
        return jnp.einsum('bhqk,bkhd->bqhd', p, vb)

    out = lax.map(one_chunk, jnp.arange(n_chunks))
    return jnp.transpose(out, (1, 0, 2, 3, 4)).reshape(B, S, H, Dh)


def setup_inputs(seed: int = 0) -> dict:
    key = jax.random.key(seed)
    ks = jax.random.split(key, 20)
    D, H, Dh = D_MODEL, N_HEADS, HEAD_DIM
    nrm = jax.random.normal
    f32 = jnp.float32
    return {
        "x": nrm(ks[0], (BATCH, SEQ, D), f32),
        "a_norm_g": 1.0 + 0.02 * nrm(ks[1], (N_A, D), f32),
        "a_w_in": nrm(ks[2], (N_A, D, 3 * D + H), f32) * D ** -0.5,
        "a_b_f": FGATE_BIAS + 0.5 * nrm(ks[3], (N_A, H), f32),
        "a_q_g": 1.0 + 0.02 * nrm(ks[4], (N_A, Dh), f32),
        "a_k_g": 1.0 + 0.02 * nrm(ks[5], (N_A, Dh), f32),
        "a_w_out": nrm(ks[6], (N_A, D, D), f32) * D ** -0.5,
        "mlp_norm_g": 1.0 + 0.02 * nrm(ks[7], (DEPTH, D), f32),
        "mlp_w1": nrm(ks[8], (DEPTH, D, D_FF), f32) * D ** -0.5,
        "mlp_w2": nrm(ks[9], (DEPTH, D_FF, D), f32) * D_FF ** -0.5,
        "kv_norm_g": 1.0 + 0.02 * nrm(ks[10], (D,), f32),
        "kv_w": nrm(ks[11], (D, 2 * D), f32) * D ** -0.5,
        "kv_k_g": 1.0 + 0.02 * nrm(ks[12], (Dh,), f32),
        "b_norm_g": 1.0 + 0.02 * nrm(ks[13], (N_B, D), f32),
        "b_w_q": nrm(ks[14], (N_B, D, D), f32) * D ** -0.5,
        "b_q_g": 1.0 + 0.02 * nrm(ks[15], (N_B, Dh), f32),
        "b_rel": 0.5 * nrm(ks[16], (N_B, H, N_REL), f32),
        "b_w_out": nrm(ks[17], (N_B, D, D), f32) * D ** -0.5,
    }


def reference(x, a_norm_g, a_w_in, a_b_f, a_q_g, a_k_g, a_w_out,
              mlp_norm_g, mlp_w1, mlp_w2,
              kv_norm_g, kv_w, kv_k_g,
              b_norm_g, b_w_q, b_q_g, b_rel, b_w_out):
    B, S, D = x.shape
    H, Dh = N_HEADS, HEAD_DIM
    h = x
    layer = 0
    for l in range(N_A):
        u = rms_norm(h, a_norm_g[l])
        proj = u @ a_w_in[l]
        q, k, v, fz = jnp.split(proj, [D, 2 * D, 3 * D], axis=-1)
        q = rms_norm(q.reshape(B, S, H, Dh), a_q_g[l])
        k = rms_norm(k.reshape(B, S, H, Dh), a_k_g[l])
        v = v.reshape(B, S, H, Dh)
        logf = jax.nn.log_sigmoid(fz.astype(jnp.float32) + a_b_f[l].astype(jnp.float32))
        o = forgetting_attention(q, k, v, logf)
        h = h + o.reshape(B, S, D) @ a_w_out[l]
        h = h + sq_relu_mlp(h, mlp_norm_g[layer], mlp_w1[layer], mlp_w2[layer])
        layer += 1
    kv = rms_norm(h, kv_norm_g) @ kv_w
    k_sh, v_sh = jnp.split(kv, [D], axis=-1)
    k_sh = rms_norm(k_sh.reshape(B, S, H, Dh), kv_k_g)
    v_sh = v_sh.reshape(B, S, H, Dh)
    for l in range(N_B):
        u = rms_norm(h, b_norm_g[l])
        q = rms_norm((u @ b_w_q[l]).reshape(B, S, H, Dh), b_q_g[l])
        o = chunked_relbias_attention(q, k_sh, v_sh, b_rel[l])
        h = h + o.reshape(B, S, D) @ b_w_out[l]
        h = h + sq_relu_mlp(h, mlp_norm_g[layer], mlp_w1[layer], mlp_w2[layer])
        layer += 1
    return h
```

```cpp
#include <hip/hip_runtime.h>
#include <hip/hip_cooperative_groups.h>
#include <cstdio>
#include <cstdint>
namespace cg = cooperative_groups;

#ifndef PROBE_REPEAT
#define PROBE_REPEAT 0
#endif
#define LAS __attribute__((address_space(3)))
#define GAS __attribute__((address_space(1)))
typedef unsigned short bf16_t;
typedef short bf16x8 __attribute__((ext_vector_type(8)));
typedef short s16x4 __attribute__((ext_vector_type(4)));
typedef float f32x4 __attribute__((ext_vector_type(4)));
typedef float f32x16 __attribute__((ext_vector_type(16)));
typedef unsigned u32x4 __attribute__((ext_vector_type(4)));
typedef unsigned u32x2 __attribute__((ext_vector_type(2)));

constexpr int BATCH = 8, SEQ = 4096, DM = 2048, NH = 16, HD = 128, FF = 8192, NREL = 320;
constexpr int M = BATCH * SEQ;
constexpr int NIN_A = 3 * DM + 256;
constexpr int NIN_B = 3 * DM;
constexpr float EPS = 1e-6f;
constexpr float SCALE = 0.08838834764831845f;
constexpr float RSC = 11.313708498984761f;

constexpr size_t MiB = 1u << 20;
constexpr size_t WS_GT = 512 * 1024;
constexpr size_t WS_LF = 1 * MiB;
constexpr size_t WS_WIN = 4 * MiB;
constexpr size_t WS_WOA = 29 * MiB;
constexpr size_t WS_W1 = 37 * MiB;
constexpr size_t WS_W2 = 101 * MiB;
constexpr size_t WS_WKVQ = 165 * MiB;
constexpr size_t WS_WOB = 189 * MiB;
constexpr size_t WS_U = 200 * MiB;
constexpr size_t WS_QKV = 328 * MiB;
constexpr size_t SEG = (size_t)M * DM;
constexpr size_t WS_U2 = 840 * MiB;
constexpr size_t WS_SSQ = 968 * MiB;
constexpr size_t WS_END = 971 * MiB;

constexpr int RING_BYTES = 131072;
constexpr int XCH_OFF = RING_BYTES;
constexpr int BARW_OFF = XCH_OFF + 8192;
constexpr int LDS_BYTES = 147456;

__device__ __forceinline__ unsigned cvt_pk_bf16(float lo, float hi) { unsigned r; asm volatile("v_cvt_pk_bf16_f32 %0, %1, %2" : "=v"(r) : "v"(lo), "v"(hi)); return r; }
#define LDS_WAIT() asm volatile("s_waitcnt lgkmcnt(0)" ::: "memory")

namespace pg8 {
constexpr int BM = 256, BK = 64, HALF = 128, HTB = HALF * BK * 2, NXCD = 8, WGM = 8;
__host__ __device__ __forceinline__ int lds_byte(int r, int c) { const int st = (r >> 4) * 2 + (c >> 5), rr = r & 15, cc = c & 31, ob = rr * 64 + cc * 2; return st * 1024 + (ob ^ (((ob >> 9) & 1) << 5)); }
__host__ __device__ __forceinline__ void stage_rc(int b, int& R, int& C) { const int st = b / 1024, sb = b % 1024, swz = sb ^ (((sb >> 9) & 1) << 5); R = (st >> 1) * 16 + swz / 64; C = (st & 1) * 32 + (swz % 64) / 2; }
__host__ __device__ __forceinline__ int perm32(int rho) { const int n = rho >> 4, i = rho & 15; return 8 * (i >> 2) + 4 * n + (i & 3); }

struct Unit { int pm, pn; };
struct Gemm { const GAS bf16_t* A; const GAS bf16_t* Bt; int M, N, K; };

struct StaticOrder {
    int nM, nN, nwg, G, c;
    __device__ void init(int M_, int N_, int G_, int c_) { nM = M_ / BM; nN = N_ / BM; nwg = nM * nN; G = G_; c = c_; }
    __device__ bool next(int i, Unit& u) const {
        const long L = (long)i * G + c; if (L >= nwg) return false;
        int wgid = (int)L; { const int q = nwg / NXCD, r = nwg % NXCD, xcd = wgid % NXCD, off = wgid / NXCD; wgid = (xcd < r ? xcd * (q + 1) : r * (q + 1) + (xcd - r) * q) + off; }
        const int nig = WGM * nN, gid = wgid / nig, fm = gid * WGM, gsz = (nM - fm) < WGM ? (nM - fm) : WGM;
        u.pm = fm + ((wgid % nig) % gsz); u.pn = (wgid % nig) / gsz; return true;
    }
};


struct EpiQKV {
    static constexpr bool PERM = true;
    GAS bf16_t* O;
    const GAS float* gt; int normmask;
    GAS float* logf; const GAS float* bfg;
    const GAS float* ssq;
    LAS float* xch;
    __device__ __forceinline__ void operator()(const f32x4 (&acc)[2][2][4][2], const Unit& u, int wr, int wc, int fr, int fq) const {
        const int t = u.pn >> 3;
        const int row0 = u.pm * BM + wr * 64 + fr;
        if (t == 3) {
            if (wc == 0 && fq < 2) {
#pragma unroll
                for (int ai = 0; ai < 2; ++ai)
#pragma unroll
                    for (int m = 0; m < 4; ++m) { const int row = row0 + ai * HALF + m * 16; const int b = row >> 12, s = row & 4095;
#pragma unroll
                        for (int n = 0; n < 2; ++n)
#pragma unroll
                            for (int j = 0; j < 4; ++j) { const int c = 8 * fq + 4 * n + j; const float z = acc[ai][0][m][n][j] + bfg[c];
                                const float lf = fminf(z, 0.f) - __logf(1.f + __expf(-fabsf(z)));
                                logf[((size_t)(b * NH + c)) * SEQ + s] = lf; } }
            }
            return;
        }
        const GAS float* gp = gt + t * HD; const bool g = (normmask >> t) & 1;
        GAS bf16_t* base = O + (size_t)t * SEG;
        const int colt = (u.pn & 7) * BM + wc * 32 + 8 * fq;
        f32x4 gv0 = (f32x4){1.f, 1.f, 1.f, 1.f}, gv1 = gv0;
        if (g) {
#pragma unroll
            for (int ai = 0; ai < 2; ++ai)
#pragma unroll
                for (int m = 0; m < 4; ++m)
#pragma unroll
                    for (int bj = 0; bj < 2; ++bj) { const f32x4 a = acc[ai][bj][m][0], b = acc[ai][bj][m][1];
                        float s = (a[0] * a[0] + a[1] * a[1]) + (a[2] * a[2] + a[3] * a[3]) + (b[0] * b[0] + b[1] * b[1]) + (b[2] * b[2] + b[3] * b[3]);
                        s += __shfl_xor(s, 16); s += __shfl_xor(s, 32);
                        if (fq == 0) xch[((ai * HALF + wr * 64 + m * 16 + fr) * 2 + bj) * 4 + wc] = s; }
            LDS_WAIT(); __builtin_amdgcn_s_barrier(); asm volatile("" ::: "memory");
            int go = wc * 32 + 8 * fq; asm volatile("" : "+v"(go));
            gv0 = *(const GAS f32x4*)(gp + go); gv1 = *(const GAS f32x4*)(gp + go + 4);
        }
#pragma unroll
        for (int ai = 0; ai < 2; ++ai)
#pragma unroll
            for (int m = 0; m < 4; ++m) { GAS bf16_t* rowp = base + (size_t)(row0 + ai * HALF + m * 16) * DM + colt;
                float r0 = 1.f, r1 = 1.f, rw = 1.f, rw2 = 1.f;
                if (ssq) { const GAS f32x4* pp = (const GAS f32x4*)(ssq + (size_t)(row0 + ai * HALF + m * 16) * 8); const f32x4 p = pp[0], q = pp[1];
                    rw2 = 1.f / ((((p[0] + p[1]) + (p[2] + p[3])) + ((q[0] + q[1]) + (q[2] + q[3]))) * (1.f / DM) + EPS); rw = sqrtf(rw2); }
                if (g) { const LAS f32x4* pp = (const LAS f32x4*)(xch + ((ai * HALF + wr * 64 + m * 16 + fr) * 2) * 4); const f32x4 p = pp[0], q = pp[1];
                    r0 = rsqrtf(((p[0] + p[1]) + (p[2] + p[3])) * rw2 * (1.f / 128.f) + EPS); r1 = rsqrtf(((q[0] + q[1]) + (q[2] + q[3])) * rw2 * (1.f / 128.f) + EPS); }
                r0 *= rw; r1 *= rw;
#pragma unroll
                for (int bj = 0; bj < 2; ++bj) { const float rr = bj ? r1 : r0; const f32x4 v0 = acc[ai][bj][m][0] * rr * gv0, v1 = acc[ai][bj][m][1] * rr * gv1;
                    u32x4 w; w.x = cvt_pk_bf16(v0[0], v0[1]); w.y = cvt_pk_bf16(v0[2], v0[3]); w.z = cvt_pk_bf16(v1[0], v1[1]); w.w = cvt_pk_bf16(v1[2], v1[3]);
                    *(GAS u32x4*)(rowp + bj * HALF) = w; }
                asm volatile("" ::: "memory"); }
    }
};
struct EpiResid {
    static constexpr bool PERM = false;
    const GAS float* base; GAS float* out; GAS bf16_t* hb; GAS float* ssq;
    LAS float* xch;
    __device__ __forceinline__ void operator()(const f32x4 (&acc)[2][2][4][2], const Unit& u, int wr, int wc, int fr, int fq) const {
        const int row0 = u.pm * BM + wr * 64 + fr, col0 = u.pn * BM + wc * 32 + 4 * fq;
#pragma unroll
        for (int ai = 0; ai < 2; ++ai)
#pragma unroll
            for (int m = 0; m < 4; ++m) { const int row = row0 + ai * HALF + m * 16; const size_t off = (size_t)row * DM + col0;
                f32x4 bs[2][2];
#pragma unroll
                for (int bj = 0; bj < 2; ++bj)
#pragma unroll
                    for (int n = 0; n < 2; ++n) bs[bj][n] = *(const GAS f32x4*)(base + off + bj * HALF + n * 16);
                float sq = 0.f;
#pragma unroll
                for (int bj = 0; bj < 2; ++bj)
#pragma unroll
                    for (int n = 0; n < 2; ++n) { const f32x4 v = acc[ai][bj][m][n] + bs[bj][n]; *(GAS f32x4*)(out + off + bj * HALF + n * 16) = v;
                        if (hb) { u32x2 w; w.x = cvt_pk_bf16(v[0], v[1]); w.y = cvt_pk_bf16(v[2], v[3]); *(GAS u32x2*)(hb + off + bj * HALF + n * 16) = w;
                            sq += (v[0] * v[0] + v[1] * v[1]) + (v[2] * v[2] + v[3] * v[3]); } }
                if (hb) { sq += __shfl_xor(sq, 16); sq += __shfl_xor(sq, 32); if (fq == 0) xch[(ai * HALF + wr * 64 + m * 16 + fr) * 4 + wc] = sq; }
                asm volatile("" ::: "memory"); }
        if (hb) { LDS_WAIT(); __builtin_amdgcn_s_barrier(); asm volatile("" ::: "memory");
            const int t = wr * 256 + wc * 64 + fq * 16 + fr;
            if (t < 256) { const f32x4 p = *(const LAS f32x4*)(xch + t * 4); ssq[(size_t)(u.pm * BM + t) * 8 + u.pn] = (p[0] + p[1]) + (p[2] + p[3]); } }
    }
};
struct EpiRelu2 {
    static constexpr bool PERM = true;
    GAS bf16_t* O; const GAS float* ssq;
    __device__ __forceinline__ void operator()(const f32x4 (&acc)[2][2][4][2], const Unit& u, int wr, int wc, int fr, int fq) const {
        const int row0 = u.pm * BM + wr * 64 + fr, col0 = u.pn * BM + wc * 32 + 8 * fq;
#pragma unroll
        for (int ai = 0; ai < 2; ++ai)
#pragma unroll
            for (int m = 0; m < 4; ++m) { GAS bf16_t* rowp = O + (size_t)(row0 + ai * HALF + m * 16) * FF + col0;
                float r2; { const GAS f32x4* pp = (const GAS f32x4*)(ssq + (size_t)(row0 + ai * HALF + m * 16) * 8); const f32x4 p = pp[0], q = pp[1];
                    r2 = 1.f / ((((p[0] + p[1]) + (p[2] + p[3])) + ((q[0] + q[1]) + (q[2] + q[3]))) * (1.f / DM) + EPS); }
#pragma unroll
                for (int bj = 0; bj < 2; ++bj) { f32x4 v0 = acc[ai][bj][m][0], v1 = acc[ai][bj][m][1];
#pragma unroll
                    for (int j = 0; j < 4; ++j) { v0[j] = fmaxf(v0[j], 0.f); v1[j] = fmaxf(v1[j], 0.f); }
                    v0 = v0 * v0 * r2; v1 = v1 * v1 * r2;
                    u32x4 w; w.x = cvt_pk_bf16(v0[0], v0[1]); w.y = cvt_pk_bf16(v0[2], v0[3]); w.z = cvt_pk_bf16(v1[0], v1[1]); w.w = cvt_pk_bf16(v1[2], v1[3]);
                    *(GAS u32x4*)(rowp + bj * HALF) = w; } }
    }
};

template <class Epi>
__device__ __forceinline__ void gemm_phase(LAS unsigned char* lds, Gemm g, const StaticOrder& S, const Epi& E) {
    int tid = threadIdx.x; asm volatile("" : "+v"(tid));
    asm volatile("" : "+s"(g.A), "+s"(g.Bt));
    const int wid = __builtin_amdgcn_readfirstlane(tid >> 6), lane = tid & 63, wr = wid >> 2, wc = wid & 3, fr = lane & 15, fq = lane >> 4;
    const int K = g.K, nt = K / BK;
    unsigned voffA[2], voffB[2];
#pragma unroll
    for (int i = 0; i < 2; ++i) { int R, C; stage_rc(tid * 16 + i * 8192, R, C); const int Rb = Epi::PERM ? ((R & ~31) + perm32(R & 31)) : R;
        voffA[i] = (unsigned)(R * K + C) * 2u; voffB[i] = (unsigned)(Rb * K + C) * 2u; }
    const size_t kstep = (size_t)(BK * 2);
    const size_t hstep = (size_t)HALF * K * 2;
    const size_t tstep = 2 * hstep;
    const unsigned ldsw = (unsigned)wid * 1024u;
    const int aoff = lds_byte(wr * 64 + fr, fq * 8), boff = lds_byte(wc * 32 + fr, fq * 8);
#define PG8_SA(b, h) (((b) * 2 + (h)) * HTB)
#define PG8_SB(b, h) ((4 + (b) * 2 + (h)) * HTB)
#define PG8_STAGE(bufoff, gbase, voff) do { _Pragma("unroll") for (int _i = 0; _i < 2; ++_i) \
        __builtin_amdgcn_global_load_lds((const GAS unsigned*)((const GAS char*)(gbase) + (voff)[_i]), (LAS unsigned*)(lds + (bufoff) + ldsw + _i * 8192), 16, 0, 0); } while (0)
#define PG8_LDA(dst, b, h) do { _Pragma("unroll") for (int m = 0; m < 4; ++m) _Pragma("unroll") for (int k = 0; k < 2; ++k) dst[m][k] = *(const LAS bf16x8*)(lds + PG8_SA(b, h) + aoff + m * 2048 + k * 1024); } while (0)
#define PG8_LDB(dst, b, h) do { _Pragma("unroll") for (int n = 0; n < 2; ++n) _Pragma("unroll") for (int k = 0; k < 2; ++k) dst[n][k] = *(const LAS bf16x8*)(lds + PG8_SB(b, h) + boff + n * 2048 + k * 1024); } while (0)
#define PG8_MMA(ai, bj, At, Bt) do { __builtin_amdgcn_s_setprio(1); _Pragma("unroll") for (int m = 0; m < 4; ++m) _Pragma("unroll") for (int n = 0; n < 2; ++n) _Pragma("unroll") for (int k = 0; k < 2; ++k) \
        acc[ai][bj][m][n] = __builtin_amdgcn_mfma_f32_16x16x32_bf16(Bt[n][k], At[m][k], acc[ai][bj][m][n], 0, 0, 0); __builtin_amdgcn_s_setprio(0); } while (0)
#define PG8_WAIT_V(n) asm volatile("s_waitcnt vmcnt(" #n ")" ::: "memory")
#define PG8_WAIT_L(n) asm volatile("s_waitcnt lgkmcnt(" #n ")" ::: "memory")
#define PG8_BAR __builtin_amdgcn_s_barrier()
#define PG8_SCHED __builtin_amdgcn_sched_barrier(0)
    Unit cur, nxt; int ui = 0;
    if (!S.next(0, cur)) return;
    f32x4 acc[2][2][4][2];
#pragma unroll
    for (int a = 0; a < 2; ++a)
#pragma unroll
        for (int b = 0; b < 2; ++b)
#pragma unroll
            for (int m = 0; m < 4; ++m)
#pragma unroll
                for (int n = 0; n < 2; ++n) acc[a][b][m][n] = (f32x4){0.f, 0.f, 0.f, 0.f};
    bf16x8 At[4][2], B0[2][2], B1[2][2];
    const GAS char* cA = (const GAS char*)g.A + (size_t)cur.pm * tstep; const GAS char* cB = (const GAS char*)g.Bt + (size_t)cur.pn * tstep;
    PG8_STAGE(PG8_SB(0, 0), cB, voffB); PG8_STAGE(PG8_SB(0, 1), cB + hstep, voffB); PG8_STAGE(PG8_SA(0, 0), cA, voffA); PG8_STAGE(PG8_SA(0, 1), cA + hstep, voffA);
    if (wr == 1) PG8_BAR;
    PG8_WAIT_V(2); PG8_BAR;
    PG8_STAGE(PG8_SB(1, 0), cB + kstep, voffB); PG8_STAGE(PG8_SA(1, 0), cA + kstep, voffA); PG8_STAGE(PG8_SB(1, 1), cB + hstep + kstep, voffB);
    PG8_WAIT_V(6); PG8_BAR;
    for (;;) {
        const bool has_next = S.next(ui + 1, nxt);
        const GAS char* nA = has_next ? (const GAS char*)g.A + (size_t)nxt.pm * tstep : cA; const GAS char* nB = has_next ? (const GAS char*)g.Bt + (size_t)nxt.pn * tstep : cB;
        for (int t = 0; t < nt; t += 2) {
            const bool last = (t == nt - 2);
            const GAS char* a1 = cA + (size_t)(t + 1) * kstep;
            const GAS char* a2 = last ? nA : cA + (size_t)(t + 2) * kstep; const GAS char* b2 = last ? nB : cB + (size_t)(t + 2) * kstep;
            const GAS char* a3 = a2 + kstep; const GAS char* b3 = b2 + kstep;
            PG8_LDB(B0, 0, 0); PG8_LDB(B1, 0, 1); PG8_SCHED; PG8_LDA(At, 0, 0); PG8_STAGE(PG8_SA(1, 1), a1 + hstep, voffA);
            PG8_WAIT_V(8); PG8_WAIT_L(0); PG8_BAR; PG8_MMA(0, 0, At, B0); PG8_MMA(0, 1, At, B1); PG8_BAR; PG8_SCHED;
            PG8_LDA(At, 0, 1); PG8_STAGE(PG8_SB(0, 0), b2, voffB); PG8_STAGE(PG8_SB(0, 1), b2 + hstep, voffB); PG8_STAGE(PG8_SA(0, 0), a2, voffA);
            PG8_WAIT_V(8); PG8_WAIT_L(0); PG8_BAR; PG8_MMA(1, 0, At, B0); PG8_MMA(1, 1, At, B1); PG8_BAR; PG8_SCHED;
            PG8_LDB(B0, 1, 0); PG8_LDB(B1, 1, 1); PG8_SCHED; PG8_LDA(At, 1, 0); PG8_STAGE(PG8_SA(0, 1), a2 + hstep, voffA);
            PG8_WAIT_V(8); PG8_WAIT_L(0); PG8_BAR; PG8_MMA(0, 0, At, B0); PG8_MMA(0, 1, At, B1); PG8_BAR; PG8_SCHED;
            PG8_LDA(At, 1, 1); PG8_STAGE(PG8_SB(1, 0), b3, voffB); PG8_STAGE(PG8_SB(1, 1), b3 + hstep, voffB); PG8_STAGE(PG8_SA(1, 0), a3, voffA);
            PG8_WAIT_V(8); PG8_WAIT_L(0); PG8_BAR; PG8_MMA(1, 0, At, B0); PG8_MMA(1, 1, At, B1); PG8_BAR; PG8_SCHED;
        }
        if (wr == 0) PG8_BAR;
        E(acc, cur, wr, wc, fr, fq);
        if (!has_next) break;
#pragma unroll
        for (int a = 0; a < 2; ++a)
#pragma unroll
            for (int b = 0; b < 2; ++b)
#pragma unroll
                for (int m = 0; m < 4; ++m)
#pragma unroll
                    for (int n = 0; n < 2; ++n) acc[a][b][m][n] = (f32x4){0.f, 0.f, 0.f, 0.f};
        cur = nxt; cA = nA; cB = nB; ++ui;
        if (wr == 1) PG8_BAR;
    }
    PG8_WAIT_V(0);
    PG8_BAR;
#undef PG8_SA
#undef PG8_SB
#undef PG8_STAGE
#undef PG8_LDA
#undef PG8_LDB
#undef PG8_MMA
#undef PG8_WAIT_V
#undef PG8_WAIT_L
#undef PG8_BAR
#undef PG8_SCHED
}
}

namespace att {
constexpr int D = 128, RS = 2048, NW = 8, QBLK = 32, KVBLK = 64, QB = NW * QBLK;
constexpr int SHM_V = KVBLK * D * 2, SHM_K = KVBLK * D * 2;
constexpr int OFF_WS = 2 * SHM_V + 2 * SHM_K;
constexpr int OFF_BIAS = OFF_WS + NW * 64 * 4;
constexpr int CST = 648;
constexpr float THR = 8.f;

#define KSWZ(row, colB) ((row) * 256 + ((colB) ^ (((row) & 7) << 4)))
#define SBAR() __builtin_amdgcn_sched_barrier(0)
__device__ __forceinline__ int v_st(int k, int c) { const int kk = (k & ~0xC) | ((k & 4) << 1) | ((k & 8) >> 1); return ((kk >> 3) * 4 + (c >> 5)) * 512 + ((kk & 7) * 32 + (c & 31)) * 2; }
__device__ __forceinline__ int v_rd_base(int lane) { return ((lane & 3) << 3) | (((lane >> 2) & 3) << 6) | (((lane >> 4) & 1) << 5) | (((lane >> 5) & 1) << 8); }
constexpr int v_rd_off(int d0, int ks, int half) { return d0 * 512 + ks * 4096 + half * 2048; }
__device__ __forceinline__ int crow(int r, int hi) { return (r & 3) + 8 * (r >> 2) + 4 * hi; }
__device__ __forceinline__ unsigned cvtpk(float lo, float hi) { unsigned r; asm volatile("v_cvt_pk_bf16_f32 %0, %1, %2" : "=v"(r) : "v"(lo), "v"(hi)); return r; }
__device__ __forceinline__ bf16x8 load8(const GAS bf16_t* p) { return *(const GAS bf16x8*)(p); }

__device__ __forceinline__ void mask_tile(f32x16& p0, f32x16& p1, int dq, unsigned W) {
    const float NEG = -__builtin_inff();
#pragma unroll
    for (int r = 0; r < 16; ++r) {
        const int c = (r & 3) + 8 * (r >> 2);
        if ((unsigned)(dq - c) >= W) p0[r] = NEG;
        if ((unsigned)(dq - c - 32) >= W) p1[r] = NEG;
    }
}
__device__ __forceinline__ void partialSM(f32x16& p0, f32x16& p1, float& m_reg, float& mn, float& alpha) {
    float pmax = p0[0];
#pragma unroll
    for (int r = 1; r < 16; ++r) pmax = fmaxf(pmax, p0[r]);
#pragma unroll
    for (int r = 0; r < 16; ++r) pmax = fmaxf(pmax, p1[r]);
    { auto rr = __builtin_amdgcn_permlane32_swap(__float_as_uint(pmax), __float_as_uint(pmax), false, false);
      pmax = fmaxf(__uint_as_float(rr[0]), __uint_as_float(rr[1])); }
    constexpr float C2 = 1.4426950408889634f * SCALE;
    if (__builtin_expect(__all((pmax - m_reg) * SCALE <= THR), 1)) { mn = m_reg; alpha = 1.f; }
    else { mn = fmaxf(m_reg, pmax); alpha = __builtin_amdgcn_exp2f((m_reg - mn) * C2); m_reg = mn; }
    const float mnL = -mn * C2;
#pragma unroll
    for (int r = 0; r < 16; ++r) p0[r] = fmaf(p0[r], C2, mnL);
#pragma unroll
    for (int r = 0; r < 16; ++r) p1[r] = fmaf(p1[r], C2, mnL);
#pragma unroll
    for (int r = 0; r < 16; ++r) p0[r] = __builtin_amdgcn_exp2f(p0[r]);
}
__device__ __forceinline__ void finishSM(f32x16& p0, f32x16& p1, float alpha, float& l_reg, bf16x8& pa0, bf16x8& pa1, bf16x8& pa2, bf16x8& pa3) {
#pragma unroll
    for (int r = 0; r < 16; ++r) p1[r] = __builtin_amdgcn_exp2f(p1[r]);
    float ps = 0;
#pragma unroll
    for (int r = 0; r < 16; ++r) ps += p0[r];
#pragma unroll
    for (int r = 0; r < 16; ++r) ps += p1[r];
    { auto rr = __builtin_amdgcn_permlane32_swap(__float_as_uint(ps), __float_as_uint(ps), false, false);
      ps = __uint_as_float(rr[0]) + __uint_as_float(rr[1]); }
    l_reg = l_reg * alpha + ps;
#define PK4(P, B_, OUT) do { unsigned a0 = cvtpk(P[B_+0], P[B_+1]), a1 = cvtpk(P[B_+2], P[B_+3]);                          \
        unsigned b0 = cvtpk(P[B_+4], P[B_+5]), b1 = cvtpk(P[B_+6], P[B_+7]);                                             \
        auto r0 = __builtin_amdgcn_permlane32_swap(a0, b0, false, false); auto r1 = __builtin_amdgcn_permlane32_swap(a1, b1, false, false); \
        u32x4 w = {r0[0], r1[0], r0[1], r1[1]}; OUT = *reinterpret_cast<bf16x8*>(&w); } while (0)
    PK4(p0, 0, pa0); PK4(p0, 8, pa1); PK4(p1, 0, pa2); PK4(p1, 8, pa3);
#undef PK4
}
template <int KB, bool SK>
__device__ __forceinline__ void qkt(f32x16& p0, f32x16& p1, const char* K_lds, int r32, int hi, const bf16x8* qr, bool act, const char* bp) {
    if (SK && !act) { const float NEG = -__builtin_inff();
#pragma unroll
        for (int r = 0; r < 16; ++r) { p0[r] = NEG; p1[r] = NEG; } return; }
    { const f32x4 b0 = *(const f32x4*)(bp), b1 = *(const f32x4*)(bp + 32), b2 = *(const f32x4*)(bp + 64), b3 = *(const f32x4*)(bp + 96);
      const f32x4 b4 = *(const f32x4*)(bp + 128), b5 = *(const f32x4*)(bp + 160), b6 = *(const f32x4*)(bp + 192), b7 = *(const f32x4*)(bp + 224);
      p0 = (f32x16){b0[0], b0[1], b0[2], b0[3], b1[0], b1[1], b1[2], b1[3], b2[0], b2[1], b2[2], b2[3], b3[0], b3[1], b3[2], b3[3]};
      p1 = (f32x16){b4[0], b4[1], b4[2], b4[3], b5[0], b5[1], b5[2], b5[3], b6[0], b6[1], b6[2], b6[3], b7[0], b7[1], b7[2], b7[3]}; }
    const char* kb[4];
#pragma unroll
    for (int dd = 0; dd < 4; ++dd) kb[dd] = K_lds + KB * SHM_K + KSWZ(r32, (dd * 16 + hi * 8) * 2);
#pragma unroll
    for (int d0 = 0; d0 < 8; ++d0) { const char* a = kb[d0 & 3] + (d0 >> 2) * 128;
        bf16x8 b0 = *reinterpret_cast<const bf16x8*>(a);
        bf16x8 b1 = *reinterpret_cast<const bf16x8*>(a + 32 * 256);
        p0 = __builtin_amdgcn_mfma_f32_32x32x16_bf16(b0, qr[d0], p0, 0, 0, 0);
        p1 = __builtin_amdgcn_mfma_f32_32x32x16_bf16(b1, qr[d0], p1, 0, 0, 0); }
}
template <int VB, bool SK>
__device__ __forceinline__ void pv_tile(f32x16* o, int vb0, bf16x8 pa0, bf16x8 pa1, bf16x8 pa2, bf16x8 pa3, bool act) {
    if (SK && !act) return;
#define TRRD(dst, off) asm volatile("ds_read_b64_tr_b16 %0, %1 offset:%2" : "=&v"(dst) : "v"(vb0), "i"(off) : "memory")
#define PV_D0(d0) do { s16x4 l0, l1, l2, l3, h0, h1, h2, h3; constexpr int b_ = VB * SHM_V + v_rd_off(d0, 0, 0); \
        TRRD(l0, b_); TRRD(h0, b_ + 2048); TRRD(l1, b_ + 4096); TRRD(h1, b_ + 6144); TRRD(l2, b_ + 8192); TRRD(h2, b_ + 10240); TRRD(l3, b_ + 12288); TRRD(h3, b_ + 14336); \
        asm volatile("s_waitcnt lgkmcnt(0)" ::: "memory"); SBAR();   \
        o[d0] = __builtin_amdgcn_mfma_f32_32x32x16_bf16(pa0, (bf16x8){l0[0], l0[1], l0[2], l0[3], h0[0], h0[1], h0[2], h0[3]}, o[d0], 0, 0, 0);   \
        o[d0] = __builtin_amdgcn_mfma_f32_32x32x16_bf16(pa1, (bf16x8){l1[0], l1[1], l1[2], l1[3], h1[0], h1[1], h1[2], h1[3]}, o[d0], 0, 0, 0);   \
        o[d0] = __builtin_amdgcn_mfma_f32_32x32x16_bf16(pa2, (bf16x8){l2[0], l2[1], l2[2], l2[3], h2[0], h2[1], h2[2], h2[3]}, o[d0], 0, 0, 0);   \
        o[d0] = __builtin_amdgcn_mfma_f32_32x32x16_bf16(pa3, (bf16x8){l3[0], l3[1], l3[2], l3[3], h3[0], h3[1], h3[2], h3[3]}, o[d0], 0, 0, 0); } while (0)
    PV_D0(0); PV_D0(1); PV_D0(2); PV_D0(3);
#undef PV_D0
#undef TRRD
}

struct BlockRef { const GAS bf16_t* Q; const GAS bf16_t* K; const GAS bf16_t* V; GAS bf16_t* O; const GAS float* bt; int P0; int jl; };
struct Seam { bf16x8 qr[8]; bf16x8 st_v0, st_v1, st_k0, st_k1; };

#define ROW(p, k0, rr) ((p) + (size_t)((k0) + (rr)) * RS + sc)
#define VMW() asm volatile("s_waitcnt vmcnt(0)" ::: "memory")
#define VMWN(n) asm volatile("s_waitcnt vmcnt(%0)" :: "i"(n) : "memory")
#define SLOAD_H(Kp, Vp, k0) do { S.st_v0 = load8(ROW(Vp, k0, sr)); S.st_v1 = load8(ROW(Vp, k0, 32 + sr));              \
                         S.st_k0 = load8(ROW(Kp, k0, sr)); S.st_k1 = load8(ROW(Kp, k0, 32 + sr)); } while (0)
#define SWRITE_HK(bf) do { *(bf16x8*)(K_lds + (bf) * SHM_K + kws) = S.st_k0; *(bf16x8*)(K_lds + (bf) * SHM_K + kws + 32 * 256) = S.st_k1; } while (0)
#define SWRITE_HV(bf) do { *(bf16x8*)(V_lds + (bf) * SHM_V + vst0) = S.st_v0; *(bf16x8*)(V_lds + (bf) * SHM_V + vst1) = S.st_v1; } while (0)
#define SWRITE_H(bf) do { SWRITE_HV(bf); SWRITE_HK(bf); } while (0)

template <int MODE>
__device__ __forceinline__ void attn_prime(const BlockRef& cur, char* lds, Seam& S) {
    int tid = threadIdx.x; asm volatile("" : "+v"(tid));
    const int wid = __builtin_amdgcn_readfirstlane(tid >> 6), lane = tid & 63, r32 = lane & 31, hi = lane >> 5;
    const int sr = tid >> 4, sc = (tid & 15) * 8, kws = KSWZ(sr, sc * 2); char* K_lds = lds + 2 * SHM_V;
    const int kb0 = cur.jl * KVBLK;
#pragma unroll
    for (int d0 = 0; d0 < 8; ++d0) S.qr[d0] = load8(cur.Q + (size_t)(wid * QBLK + r32) * RS + d0 * 16 + hi * 8);
    SLOAD_H(cur.K, cur.V, kb0); VMW(); SWRITE_HK(0);
    __syncthreads();
}
template <int MODE>
__device__ __forceinline__ void attn_block(const BlockRef& cur, const BlockRef& nxt, char* lds, Seam& S) {
    constexpr bool SK = false;
    int tid = threadIdx.x; asm volatile("" : "+v"(tid));
    const int wid = __builtin_amdgcn_readfirstlane(tid >> 6), lane = tid & 63, r32 = lane & 31, hi = lane >> 5;
    const int j_lo = cur.jl;
    const int j_hi = (cur.P0 >> 6) + 4;
    const int NT = j_hi - j_lo;
    const int kbn = nxt.jl * KVBLK;
    const int qlo = cur.P0 + wid * QBLK, qm = qlo + r32 - 4 * hi;
    const int cw = (cur.P0 >> 6) + (wid >> 1);
    char* V_lds = lds; char* K_lds = lds + 2 * SHM_V;
    float* ws = (float*)(lds + OFF_WS) + wid * 64; float* li_l = ws, * al_l = ws + 32;
    { float* tab = (float*)(lds + OFF_BIAS);
      if (MODE == 0) { const float cref = cur.bt[cur.P0]; const int nk = cur.P0 + QB;
          _Pragma("clang loop vectorize(disable) unroll(disable)") for (int i = j_lo * KVBLK + tid; i < nk; i += NW * 64) tab[i] = (cref - cur.bt[i]) * RSC; }
      else { _Pragma("clang loop vectorize(disable) unroll(disable)") for (int i = tid; i < 4 * CST; i += NW * 64) { const int a = i / CST, j = i - a * CST + a; int dist = 575 - j; dist = dist < -63 ? -63 : (dist > 256 ? 256 : dist);
                 tab[i] = cur.bt[dist + 63] * RSC; } }
      __syncthreads(); }
    int bl;
    if (MODE == 0) bl = OFF_BIAS + 16 * hi;
    else { const int tpos = cur.P0 + wid * QBLK + r32; const int a = (575 - tpos) & 3; bl = OFF_BIAS + a * (CST * 4) + 4 * (575 - tpos - a + 4 * hi); }
    asm volatile("" : "+v"(bl));
    float m_reg = -1e30f, l_reg = 0; f32x16 o[4] = {};
    const int sr = tid >> 4, sc = (tid & 15) * 8, vst0 = v_st(sr, sc), vst1 = v_st(32 + sr, sc), kws = KSWZ(sr, sc * 2);
    const int vb0 = (int)(uintptr_t)V_lds + v_rd_base(lane);
    const GAS bf16_t* Kh = cur.K; const GAS bf16_t* Vh = cur.V;
#define RESC(a) do { if (__any((a) < 1.f)) { if (hi == 0) al_l[r32] = (a); asm volatile("s_waitcnt lgkmcnt(0)" ::: "memory");              \
                     for (int d_ = 0; d_ < 4; ++d_) for (int r = 0; r < 16; ++r) o[d_][r] *= al_l[crow(r, hi)]; } } while (0)
#define KBASE(t) ((j_lo + (t)) * KVBLK)
#define BP(t) (lds + (bl + ((MODE == 0 || ACT(t)) ? KBASE(t) : cw * KVBLK) * 4))
#define ACT(t) (MODE == 0 ? true : ((j_lo + (t)) <= cw && (j_lo + (t)) >= cw - 8))
#define MASKT(P0_, P1_, t) do { if (MODE == 0) { const int kb_ = KBASE(t); if (kb_ + KVBLK - 1 > qlo) mask_tile(P0_, P1_, qm - kb_, 0x7fffffffu); } \
        else if (!ACT(t)) { const float NEG_ = -__builtin_inff(); _Pragma("unroll") for (int r_ = 0; r_ < 16; ++r_) { P0_[r_] = NEG_; P1_[r_] = NEG_; } } } while (0)
    constexpr int NQL = 8;
#define SEAM_K0() do { VMWN(NQL); SWRITE_HK(0); SBAR(); } while (0)
    f32x16 pA0, pA1, pB0, pB1; float mnA, mnB, alA, alB; bf16x8 pa0, pa1, pa2, pa3;
    SWRITE_HV(0); SBAR();
    if (NT > 1) { SLOAD_H(Kh, Vh, KBASE(1)); }
    SBAR(); qkt<0, SK>(pA0, pA1, K_lds, r32, hi, S.qr, ACT(0), BP(0));
    MASKT(pA0, pA1, 0); partialSM(pA0, pA1, m_reg, mnA, alA);
    if (NT > 1) { VMW(); SWRITE_H(1); }
    __syncthreads();
#define HALF_STEP(PX0, PX1, mnX, alX, PY0, PY1, alY, t, KB, VB, SB) do {                                                      \
        SBAR(); qkt<KB, SK>(PX0, PX1, K_lds, r32, hi, S.qr, ACT(t), BP(t));                                      \
        finishSM(PY0, PY1, alY, l_reg, pa0, pa1, pa2, pa3); SBAR();                                                           \
        if ((t) + 1 < NT) { SLOAD_H(Kh, Vh, KBASE((t) + 1)); SBAR(); }                                                        \
        pv_tile<VB, SK>(o, vb0, pa0, pa1, pa2, pa3, ACT((t) - 1)); MASKT(PX0, PX1, (t)); partialSM(PX0, PX1, m_reg, mnX, alX); \
        __syncthreads();                                                                                                      \
        if ((t) + 1 < NT) { VMW(); SWRITE_H(SB); }                                                                            \
        RESC(alX); __syncthreads(); } while (0)
    for (int t = 1; t + 1 < NT; t += 2) {
        HALF_STEP(pB0, pB1, mnB, alB, pA0, pA1, alA, t, 1, 0, 0);
        HALF_STEP(pA0, pA1, mnA, alA, pB0, pB1, alB, t + 1, 0, 1, 1);
    }
    const bool even = (NT & 1) == 0;
    if (even) { SBAR(); qkt<1, SK>(pB0, pB1, K_lds, r32, hi, S.qr, ACT(NT - 1), BP(NT - 1)); SBAR(); }
    SLOAD_H(nxt.K, nxt.V, kbn); SBAR();
#pragma unroll
    for (int d0 = 0; d0 < 8; ++d0) S.qr[d0] = load8(nxt.Q + (size_t)(wid * QBLK + r32) * RS + d0 * 16 + hi * 8);
    SBAR();
    finishSM(pA0, pA1, alA, l_reg, pa0, pa1, pa2, pa3); SBAR();
    pv_tile<0, SK>(o, vb0, pa0, pa1, pa2, pa3, ACT(even ? NT - 2 : NT - 1));
    if (even) { MASKT(pB0, pB1, NT - 1); partialSM(pB0, pB1, m_reg, mnB, alB); __syncthreads(); RESC(alB);
        finishSM(pB0, pB1, alB, l_reg, pa0, pa1, pa2, pa3); SBAR(); pv_tile<1, SK>(o, vb0, pa0, pa1, pa2, pa3, ACT(NT - 1)); }
    SBAR(); SEAM_K0();
    if (hi == 0) li_l[r32] = l_reg; asm volatile("s_waitcnt lgkmcnt(0)" ::: "memory");
    float rli[16];
#pragma unroll
    for (int r = 0; r < 16; ++r) rli[r] = __builtin_amdgcn_rcpf(li_l[crow(r, hi)]);
    GAS bf16_t* Ow = cur.O + (size_t)(wid * QBLK) * RS;
#pragma unroll
    for (int r = 0; r < 16; ++r) { const int orow = crow(r, hi);
#pragma unroll
        for (int d0 = 0; d0 < 4; ++d0) { const float v = o[d0][r] * rli[r];
            const float vn = __shfl_xor(v, 1);
            if ((r32 & 1) == 0) *(GAS unsigned*)(Ow + (size_t)orow * RS + d0 * 32 + r32) = cvtpk(v, vn); } }
    __syncthreads();
#undef RESC
#undef KBASE
#undef BP
#undef ACT
#undef MASKT
#undef SEAM_K0
#undef HALF_STEP
}
#undef ROW
#undef VMW
#undef VMWN
#undef SLOAD_H
#undef SWRITE_HK
#undef SWRITE_HV
#undef SWRITE_H

template <int MODE>
__device__ __forceinline__ BlockRef block_ref(int n, int vcu, int G, const GAS bf16_t* Q, const GAS bf16_t* K, const GAS bf16_t* V, GAS bf16_t* O, const GAS float* bt, const GAS int* jtab) {
    int bh, qb;
    if (MODE == 0) {
        if (G == 2 * BATCH * NH) { bh = vcu >> 1; const int p = n >> 1; qb = (vcu & 1) ? ((n & 1) ? 13 - 4 * p : 14 - 4 * p) : ((n & 1) ? 12 - 4 * p : 15 - 4 * p); }
        else { const int L = vcu + n * G; bh = L >> 4; qb = 15 - (L & 15); }
    } else { const int L = vcu + n * G; bh = L >> 4; qb = L & 15; }
    const int b = bh >> 4, h = bh & 15;
    BlockRef r; const size_t row0 = (size_t)b * SEQ;
    r.Q = Q + (row0 + (size_t)qb * QB) * RS + h * D; r.O = O + (row0 + (size_t)qb * QB) * RS + h * D;
    r.K = K + row0 * RS + h * D; r.V = V + row0 * RS + h * D; r.P0 = qb * QB;
    r.bt = MODE == 0 ? bt + (size_t)bh * SEQ : bt + h * NREL;
    if (MODE == 0) r.jl = jtab[bh * 16 + qb]; else { const int j = (r.P0 >> 6) - 8; r.jl = j > 0 ? j : 0; }
    return r;
}
template <int MODE>
__device__ __forceinline__ void attn_phase(char* lds, int vcu, int G, const GAS bf16_t* Q, const GAS bf16_t* K, const GAS bf16_t* V, GAS bf16_t* O, const GAS float* bt, const GAS int* jtab) {
    asm volatile("" : "+s"(Q), "+s"(K), "+s"(V), "+s"(O), "+s"(bt), "+s"(vcu), "+s"(jtab));
    const int total = BATCH * NH * 16;
    int nblk = 0; for (int L = vcu; L < total; L += G) ++nblk;
    if (nblk == 0) return;
    BlockRef cur = block_ref<MODE>(0, vcu, G, Q, K, V, O, bt, jtab);
    Seam S;
    attn_prime<MODE>(cur, lds, S);
    for (int n = 0; n < nblk; ++n) {
        const bool last = (n + 1 == nblk);
        const BlockRef nxt = last ? cur : block_ref<MODE>(n + 1, vcu, G, Q, K, V, O, bt, jtab);
        attn_block<MODE>(cur, nxt, lds, S);
        cur = nxt;
    }
}
}


#define XB_TMO      128
#define XB_XCNT(j)  (256  + 64 * (j))
#define XB_XSUB(j)  (1280 + 64 * (j))
#define XB_XGEN(j)  (2304 + 64 * (j))
#define XB_TOP      3328
#define XB_TOPGEN   3392
#define XCD_BAR_WORDS 3456
#define XB_SPIN_CAP (1u << 18)
__device__ __forceinline__ unsigned xb_ld(unsigned* p)              { return __hip_atomic_load(p, __ATOMIC_RELAXED, __HIP_MEMORY_SCOPE_AGENT); }
__device__ __forceinline__ unsigned xb_add(unsigned* p, unsigned v) { return __hip_atomic_fetch_add(p, v, __ATOMIC_RELAXED, __HIP_MEMORY_SCOPE_AGENT); }
__device__ __forceinline__ unsigned xb_xcc_id() { return (unsigned)__builtin_amdgcn_s_getreg((3 << 11) | 20) & 0xFu; }
#define XB_SPIN(cond, bar) do { unsigned _sp = 0; while (cond) { __builtin_amdgcn_s_sleep(1); \
    if ((++_sp & 255u) == 0u) { if (xb_ld(&(bar)[XB_TMO])) break; if (_sp > XB_SPIN_CAP) { atomicAdd(&(bar)[XB_TMO], 1u); break; } } } } while (0)
struct XcdBarrier { unsigned* bar; unsigned x; volatile LAS unsigned* st; };
__device__ __forceinline__ XcdBarrier xcd_barrier_post(unsigned* bar, volatile LAS unsigned* st) {
    XcdBarrier b; b.bar = bar; b.x = xb_xcc_id(); b.st = st;
    if (threadIdx.x == 0) (void)xb_add(&bar[XB_XCNT(b.x)], 1u);
    return b;
}
__device__ __forceinline__ void xcd_barrier_complete(unsigned* bar, unsigned x, unsigned& nloc, unsigned& nx) {
    const unsigned G = gridDim.x * gridDim.y * gridDim.z;
    unsigned sum, cnt, mine, sp = 0u;
    for (;;) {
        sum = 0u; cnt = 0u; mine = 0u;
#pragma unroll
        for (unsigned j = 0; j < 16; ++j) { const unsigned c = xb_ld(&bar[XB_XCNT(j)]); sum += c; cnt += (c > 0u) ? 1u : 0u; mine = (j == x) ? c : mine; }
        if (sum == G) break;
        __builtin_amdgcn_s_sleep(1);
        if ((++sp & 255u) == 0u) { if (xb_ld(&bar[XB_TMO])) break; if (sp > XB_SPIN_CAP) { atomicAdd(&bar[XB_TMO], 1u); break; } }
    }
    nloc = mine > 0u ? mine : 1u; nx = cnt > 0u ? cnt : 1u;
}
__device__ __forceinline__ void xcd_barrier(const XcdBarrier& b) {
    asm volatile("s_waitcnt vmcnt(0)" ::: "memory");
    __syncthreads();
    if (threadIdx.x == 0) {
        unsigned* bar = b.bar;
        __builtin_amdgcn_s_waitcnt(0);
        unsigned nloc = b.st[0], nx = b.st[1];
        if (nloc == 0u) { xcd_barrier_complete(bar, b.x, nloc, nx); b.st[0] = nloc; b.st[1] = nx; }
        const unsigned old = xb_add(&bar[XB_XSUB(b.x)], 1u);
        const unsigned gen = old / nloc;
        if (old + 1u == (gen + 1u) * nloc) {
            __builtin_amdgcn_fence(__ATOMIC_RELEASE, "agent");
            asm volatile("s_waitcnt vmcnt(0)" ::: "memory");
            const unsigned og = xb_add(&bar[XB_TOP], 1u);
            const unsigned tg = og / nx;
            if (og + 1u == (tg + 1u) * nx) xb_add(&bar[XB_TOPGEN], 1u);
            else XB_SPIN(xb_ld(&bar[XB_TOPGEN]) == tg, bar);
            __builtin_amdgcn_fence(__ATOMIC_ACQUIRE, "agent");
            xb_add(&bar[XB_XGEN(b.x)], 1u);
            asm volatile("s_waitcnt vmcnt(0)" ::: "memory");
        } else {
            XB_SPIN(xb_ld(&bar[XB_XGEN(b.x)]) == gen, bar);
            __builtin_amdgcn_fence(__ATOMIC_ACQUIRE, "agent");
            asm volatile("s_waitcnt vmcnt(0)" ::: "memory");
        }
    }
    __syncthreads();
}

__device__ __forceinline__ float wave_sum(float v) {
#pragma unroll
    for (int o = 1; o < 64; o <<= 1) v += __shfl_xor(v, o);
    return v;
}
__device__ __forceinline__ unsigned f2bf(float f) { unsigned u = __builtin_bit_cast(unsigned, f); return (u + 0x7fffu + ((u >> 16) & 1u)) >> 16; }
__device__ __forceinline__ unsigned pk2(float lo, float hi) { return f2bf(lo) | (f2bf(hi) << 16); }
__device__ __forceinline__ void transpose_item(const GAS float* W, int K, int N, int ldn, const GAS float* gk, GAS bf16_t* WT, int row_off, LAS float* scr, int item, int nblk, int lane) {
    const int kb = item / nblk, nb = item - kb * nblk, k0 = 64 * kb, n0 = 32 * nb;
    const int n = n0 + (lane & 31);
    float wv[32];
#pragma unroll
    for (int i = 0; i < 32; ++i) { const int kk = 2 * i + (lane >> 5); wv[i] = 0.f; if (n < N) wv[i] = __builtin_nontemporal_load(W + (size_t)(k0 + kk) * ldn + n); }
#pragma unroll
    for (int i = 0; i < 32; ++i) { const int kk = 2 * i + (lane >> 5); float v = wv[i]; if (gk) v *= gk[k0 + kk]; scr[kk * 33 + (lane & 31)] = v; }
    LDS_WAIT(); asm volatile("" ::: "memory");
    const int c = lane & 7;
#pragma unroll
    for (int j = 0; j < 4; ++j) { const int nn = (lane >> 3) + 8 * j; const LAS float* s = scr + (8 * c) * 33 + nn;
        u32x4 o; o.x = pk2(s[0 * 33], s[1 * 33]); o.y = pk2(s[2 * 33], s[3 * 33]); o.z = pk2(s[4 * 33], s[5 * 33]); o.w = pk2(s[6 * 33], s[7 * 33]);
        *(GAS u32x4*)(WT + (size_t)(row_off + n0 + nn) * K + k0 + 8 * c) = o; }
    LDS_WAIT(); asm volatile("" ::: "memory");
}
__device__ __forceinline__ void rms_row(const GAS float* xrow, GAS bf16_t* orow, int lane) {
    asm volatile("" : "+v"(lane));
    const GAS f32x4* xr = (const GAS f32x4*)xrow + lane;
    f32x4 v[8]; float s = 0.f;
#pragma unroll
    for (int j = 0; j < 8; ++j) { v[j] = xr[64 * j]; s += (v[j][0] * v[j][0] + v[j][1] * v[j][1]) + (v[j][2] * v[j][2] + v[j][3] * v[j][3]); }
    const float r = rsqrtf(wave_sum(s) * (1.f / DM) + EPS);
    GAS u32x2* o8 = (GAS u32x2*)orow + lane;
#pragma unroll
    for (int j = 0; j < 8; ++j) { u32x2 w; w.x = pk2(v[j][0] * r, v[j][1] * r); w.y = pk2(v[j][2] * r, v[j][3] * r); o8[64 * j] = w; }
}

struct Args { const float* in[18]; float* out; unsigned char* ws; };
enum { I_X = 0, I_ANG, I_AWIN, I_ABF, I_AQG, I_AKG, I_AWOUT, I_MNG, I_W1, I_W2, I_KVNG, I_KVW, I_KVKG, I_BNG, I_BWQ, I_BQG, I_BREL, I_BWOUT };

__global__ void __launch_bounds__(512, 2) fwd_megakernel(Args a) {
    extern __shared__ __attribute__((aligned(16))) unsigned char lds[];
    cg::grid_group grid = cg::this_grid();
    LAS unsigned char* L = (LAS unsigned char*)lds;
    const int wave = __builtin_amdgcn_readfirstlane(threadIdx.x >> 6);
    const int G = gridDim.x, bx = blockIdx.x;
    const int vcu = (G % 8 == 0) ? (bx % 8) * (G / 8) + bx / 8 : bx;
    GAS unsigned char* ws = (GAS unsigned char*)a.ws;
    GAS float* LF = (GAS float*)(ws + WS_LF); GAS float* GT = (GAS float*)(ws + WS_GT); GAS int* JT = (GAS int*)(ws + WS_GT + 8192);
    GAS bf16_t* WIN = (GAS bf16_t*)(ws + WS_WIN); GAS bf16_t* WOA = (GAS bf16_t*)(ws + WS_WOA); GAS bf16_t* W1T = (GAS bf16_t*)(ws + WS_W1); GAS bf16_t* W2T = (GAS bf16_t*)(ws + WS_W2);
    GAS bf16_t* WKVQ = (GAS bf16_t*)(ws + WS_WKVQ); GAS bf16_t* WOB = (GAS bf16_t*)(ws + WS_WOB);
    GAS bf16_t* U2 = (GAS bf16_t*)(ws + WS_U2); GAS float* SSQ = (GAS float*)(ws + WS_SSQ);
    GAS bf16_t* U = (GAS bf16_t*)(ws + WS_U); GAS bf16_t* QKV = (GAS bf16_t*)(ws + WS_QKV); GAS bf16_t* HID = QKV;
    GAS float* out = (GAS float*)a.out;
#define IN(i) ((const GAS float*)a.in[i])
    const int gw = vcu * 8 + wave, NGW = G * 8;
    if (threadIdx.x < 4) ((LAS unsigned*)(L + BARW_OFF))[threadIdx.x] = 0u;
    __syncthreads();
    const XcdBarrier xbar = xcd_barrier_post((unsigned*)a.ws, (volatile LAS unsigned*)(L + BARW_OFF));
#define GRID_BAR() xcd_barrier(xbar)

    for (int rep_ = 0; rep_ < (PROBE_REPEAT == 1 ? 2 : 1); ++rep_) {
        int tid = threadIdx.x; asm volatile("" : "+v"(tid)); const int lane = tid & 63;
        LAS float* scr = (LAS float*)(L + wave * 16384);
        constexpr int I0 = 32 * 200, I1 = 32 * 64, I2 = 32 * 256, I3 = 128 * 64, I4 = 32 * 128, I5 = 32 * 64, I6 = 32 * 64;
        constexpr int NITEMS = I0 + I1 + 2 * I2 + 2 * I3 + I4 + I5 + I6;
        for (int it = gw; it < NITEMS; it += NGW) {
            int r = it;
            if (r < I0) { transpose_item(IN(I_AWIN), DM, 3 * DM + NH, 3 * DM + NH, IN(I_ANG), WIN, 0, scr, r, 200, lane); continue; } r -= I0;
            if (r < I1) { transpose_item(IN(I_AWOUT), DM, DM, DM, nullptr, WOA, 0, scr, r, 64, lane); continue; } r -= I1;
            if (r < I2) { transpose_item(IN(I_W1), DM, FF, FF, IN(I_MNG), W1T, 0, scr, r, 256, lane); continue; } r -= I2;
            if (r < I2) { transpose_item(IN(I_W1) + (size_t)DM * FF, DM, FF, FF, IN(I_MNG) + DM, W1T + (size_t)FF * DM, 0, scr, r, 256, lane); continue; } r -= I2;
            if (r < I3) { transpose_item(IN(I_W2), FF, DM, DM, nullptr, W2T, 0, scr, r, 64, lane); continue; } r -= I3;
            if (r < I3) { transpose_item(IN(I_W2) + (size_t)FF * DM, FF, DM, DM, nullptr, W2T + (size_t)DM * FF, 0, scr, r, 64, lane); continue; } r -= I3;
            if (r < I4) { transpose_item(IN(I_KVW), DM, 2 * DM, 2 * DM, IN(I_KVNG), WKVQ, 0, scr, r, 128, lane); continue; } r -= I4;
            if (r < I5) { transpose_item(IN(I_BWQ), DM, DM, DM, IN(I_BNG), WKVQ, 2 * DM, scr, r, 64, lane); continue; } r -= I5;
            transpose_item(IN(I_BWOUT), DM, DM, DM, nullptr, WOB, 0, scr, r, 64, lane);
        }
        for (int m = gw; m < M; m += NGW) rms_row(IN(I_X) + (size_t)m * DM, U + (size_t)m * DM, lane);
        if (bx == 0 && tid < HD) { GT[tid] = IN(I_AQG)[tid]; GT[HD + tid] = IN(I_AKG)[tid]; GT[2 * HD + tid] = 1.f;
            GT[3 * HD + tid] = IN(I_KVKG)[tid]; GT[4 * HD + tid] = 1.f; GT[5 * HD + tid] = IN(I_BQG)[tid]; }
    }
    grid.sync();

    {
        pg8::Gemm g{U, WIN, M, NIN_A, DM}; pg8::StaticOrder S; S.init(M, NIN_A, G, bx);
        pg8::EpiQKV E{QKV, GT, 3, LF, IN(I_ABF), nullptr, (LAS float*)(L + XCH_OFF)};
#ifndef NO_EPIQKV_1
        pg8::gemm_phase<pg8::EpiQKV>(L, g, S, E);
#endif
    }
    GRID_BAR();

    if (bx < BATCH * NH) {
        int tid = threadIdx.x; asm volatile("" : "+v"(tid)); const int lane = tid & 63;
        GAS float* p = LF + (size_t)bx * SEQ + tid * 8;
        f32x4 v0 = *(const GAS f32x4*)p, v1 = *(const GAS f32x4*)(p + 4);
        v0[1] += v0[0]; v0[2] += v0[1]; v0[3] += v0[2]; v1[0] += v0[3]; v1[1] += v1[0]; v1[2] += v1[1]; v1[3] += v1[2];
        const float tot = v1[3]; float x = tot;
#pragma unroll
        for (int o = 1; o < 64; o <<= 1) { const float t = __shfl_up(x, o); if (lane >= o) x += t; }
        LAS float* wt = (LAS float*)L;
        LAS float* cs = (LAS float*)(L + 256);
        if (lane == 63) wt[wave] = x;
        float gq = 0.f, gk = 0.f;
        if (tid < 64) { gq = fmaxf(fabsf(GT[tid]), fabsf(GT[tid + 64])); gk = fmaxf(fabsf(GT[HD + tid]), fabsf(GT[HD + tid + 64]));
#pragma unroll
            for (int o = 1; o < 64; o <<= 1) { gq = fmaxf(gq, __shfl_xor(gq, o)); gk = fmaxf(gk, __shfl_xor(gk, o)); }
            if (tid == 0) wt[8] = 2.f * 1.02f * RSC * gq * gk + 30.f; }
        __syncthreads();
        float off = x - tot;
        for (int w = 0; w < wave; ++w) off += wt[w];
        v0 = v0 + off; v1 = v1 + off;
        *(GAS f32x4*)p = v0; *(GAS f32x4*)(p + 4) = v1;
        *(LAS f32x4*)(cs + tid * 8) = v0; *(LAS f32x4*)(cs + tid * 8 + 4) = v1;
        __syncthreads();
        if (tid < 16) { const int P0 = tid * 256; const float cq = cs[P0], T = wt[8]; int t = 0;
            while (t < (P0 >> 6) && cq - cs[64 * t + 63] < -T) ++t;
            JT[bx * 16 + tid] = t; }
    }
    GRID_BAR();

#ifndef NO_ATT0
    att::attn_phase<0>((char*)lds, vcu, G, QKV, QKV + SEG, QKV + 2 * SEG, U, LF, JT);
#endif
#if PROBE_REPEAT == 3
    __syncthreads(); att::attn_phase<0>((char*)lds, vcu, G, QKV, QKV + SEG, QKV + 2 * SEG, U, LF, JT);
#endif
    GRID_BAR();

    {
        pg8::Gemm g{U, WOA, M, DM, DM}; pg8::StaticOrder S; S.init(M, DM, G, bx);
        pg8::EpiResid E{IN(I_X), out, U2, SSQ, (LAS float*)(L + XCH_OFF)};
#ifndef NO_EPIRESID_1
        pg8::gemm_phase<pg8::EpiResid>(L, g, S, E);
#endif
    }
    GRID_BAR();

#define MLP_BLOCK(layer, SSQ_IN, HB_OUT, SSQ_OUT) do { \
        { pg8::Gemm g{U2, W1T + (size_t)(layer) * FF * DM, M, FF, DM}; pg8::StaticOrder S; S.init(M, FF, G, bx); \
          pg8::EpiRelu2 E{HID, SSQ_IN}; \
          pg8::gemm_phase<pg8::EpiRelu2>(L, g, S, E); \
          if (PROBE_REPEAT == 6 && (layer) == 0) { __syncthreads(); pg8::gemm_phase<pg8::EpiRelu2>(L, g, S, E); } } \
        GRID_BAR(); \
        { pg8::Gemm g{HID, W2T + (size_t)(layer) * DM * FF, M, DM, FF}; pg8::StaticOrder S; S.init(M, DM, G, bx); \
          pg8::EpiResid E{out, out, HB_OUT, SSQ_OUT, (LAS float*)(L + XCH_OFF)}; \
          pg8::gemm_phase<pg8::EpiResid>(L, g, S, E); } } while (0)
    MLP_BLOCK(0, SSQ, U2, SSQ + (size_t)8 * M);
    GRID_BAR();
    {
        pg8::Gemm g{U2, WKVQ, M, NIN_B, DM}; pg8::StaticOrder S; S.init(M, NIN_B, G, bx);
        pg8::EpiQKV E{QKV, GT + 3 * HD, 5, nullptr, nullptr, SSQ + (size_t)8 * M, (LAS float*)(L + XCH_OFF)};
        pg8::gemm_phase<pg8::EpiQKV>(L, g, S, E);
    }
    GRID_BAR();
    att::attn_phase<1>((char*)lds, vcu, G, QKV + 2 * SEG, QKV, QKV + SEG, U, IN(I_BREL), JT);
#if PROBE_REPEAT == 10
    __syncthreads(); att::attn_phase<1>((char*)lds, vcu, G, QKV + 2 * SEG, QKV, QKV + SEG, U, IN(I_BREL), JT);
#endif
    GRID_BAR();
    {
        pg8::Gemm g{U, WOB, M, DM, DM}; pg8::StaticOrder S; S.init(M, DM, G, bx);
        pg8::EpiResid E{out, out, U2, SSQ + (size_t)16 * M, (LAS float*)(L + XCH_OFF)};
        pg8::gemm_phase<pg8::EpiResid>(L, g, S, E);
    }
    GRID_BAR();
    MLP_BLOCK(1, SSQ + (size_t)16 * M, (GAS bf16_t*)nullptr, (GAS float*)nullptr);
#undef MLP_BLOCK
}

extern "C" void kernel_launch(void* const* d_in, const int* in_sizes, int n_in, void* d_out, int out_size, void* d_ws, size_t ws_size, hipStream_t stream) {
    static int grid = 0;
    if (grid == 0) {
        if (n_in != 18 || in_sizes[0] != M * DM || out_size != M * DM || ws_size < WS_END) {
            fprintf(stderr, "kernel_launch: shape mismatch (n_in %d in0 %d out %d ws %zu)\n", n_in, n_in > 0 ? in_sizes[0] : -1, out_size, ws_size); grid = -1; return; }
        int dev = 0, cus = 0, per_cu = 0;
        (void)hipGetDevice(&dev);
        if (hipDeviceGetAttribute(&cus, hipDeviceAttributeMultiprocessorCount, dev) != hipSuccess || cus <= 0) cus = 256;
        if (hipFuncSetAttribute((const void*)fwd_megakernel, hipFuncAttributeMaxDynamicSharedMemorySize, LDS_BYTES) != hipSuccess) { fprintf(stderr, "kernel_launch: hipFuncSetAttribute failed\n"); grid = -1; return; }
        if (hipOccupancyMaxActiveBlocksPerMultiprocessor(&per_cu, (const void*)fwd_megakernel, 512, LDS_BYTES) != hipSuccess || per_cu < 1) { fprintf(stderr, "kernel_launch: occupancy query says %d\n", per_cu); per_cu = 1; }
        (void)hipGetLastError();
        grid = cus * per_cu;
    }
    if (grid < 0) return;
    if (hipMemsetAsync(d_ws, 0, 16384, stream) != hipSuccess) { fprintf(stderr, "kernel_launch: memset failed\n"); return; }
    Args a{};
    for (int i = 0; i < 18; ++i) a.in[i] = (const float*)d_in[i];
    a.out = (float*)d_out; a.ws = (unsigned char*)d_ws;
    void* args[] = {&a};
    hipError_t e = hipLaunchCooperativeKernel((const void*)fwd_megakernel, dim3(grid), dim3(512), args, LDS_BYTES, stream);
    if (e != hipSuccess) fprintf(stderr, "kernel_launch: cooperative launch failed: %s (grid %d)\n", hipGetErrorString(e), grid);
}
```

```cpp
#include <hip/hip_runtime.h>
#include <hip/hip_cooperative_groups.h>
#include <cstdio>
#include <cstdint>
namespace cg = cooperative_groups;

#ifndef PROBE_REPEAT
#define PROBE_REPEAT 0
#endif
#define LAS __attribute__((address_space(3)))
#define GAS __attribute__((address_space(1)))
typedef unsigned short bf16_t;
typedef short bf16x8 __attribute__((ext_vector_type(8)));
typedef short s16x4 __attribute__((ext_vector_type(4)));
typedef float f32x4 __attribute__((ext_vector_type(4)));
typedef float f32x16 __attribute__((ext_vector_type(16)));
typedef unsigned u32x4 __attribute__((ext_vector_type(4)));
typedef unsigned u32x2 __attribute__((ext_vector_type(2)));

constexpr int BATCH = 8, SEQ = 4096, DM = 2048, NH = 16, HD = 128, FF = 8192, NREL = 320;
constexpr int M = BATCH * SEQ;
constexpr int NIN_A = 3 * DM + 256;
constexpr int NIN_B = 3 * DM;
constexpr float EPS = 1e-6f;
constexpr float SCALE = 0.08838834764831845f;
constexpr float RSC = 11.313708498984761f;

constexpr size_t MiB = 1u << 20;
constexpr size_t WS_GT = 512 * 1024;
constexpr size_t WS_LF = 1 * MiB;
constexpr size_t WS_WIN = 4 * MiB;
constexpr size_t WS_WOA = 29 * MiB;
constexpr size_t WS_W1 = 37 * MiB;
constexpr size_t WS_W2 = 101 * MiB;
constexpr size_t WS_WKVQ = 165 * MiB;
constexpr size_t WS_WOB = 189 * MiB;
constexpr size_t WS_U = 200 * MiB;
constexpr size_t WS_QKV = 328 * MiB;
constexpr size_t SEG = (size_t)M * DM;
constexpr size_t WS_U2 = 840 * MiB;
constexpr size_t WS_SSQ = 968 * MiB;
constexpr size_t WS_END = 971 * MiB;

constexpr int RING_BYTES = 131072;
constexpr int XCH_OFF = RING_BYTES;
constexpr int BARW_OFF = XCH_OFF + 8192;
constexpr int LDS_BYTES = 147456;

__device__ __forceinline__ unsigned cvt_pk_bf16(float lo, float hi) { unsigned r; asm volatile("v_cvt_pk_bf16_f32 %0, %1, %2" : "=v"(r) : "v"(lo), "v"(hi)); return r; }
#define LDS_WAIT() asm volatile("s_waitcnt lgkmcnt(0)" ::: "memory")

namespace pg8 {
constexpr int BM = 256, BK = 64, HALF = 128, HTB = HALF * BK * 2, NXCD = 8, WGM = 8;
__host__ __device__ __forceinline__ int lds_byte(int r, int c) { const int st = (r >> 4) * 2 + (c >> 5), rr = r & 15, cc = c & 31, ob = rr * 64 + cc * 2; return st * 1024 + (ob ^ (((ob >> 9) & 1) << 5)); }
__host__ __device__ __forceinline__ void stage_rc(int b, int& R, int& C) { const int st = b / 1024, sb = b % 1024, swz = sb ^ (((sb >> 9) & 1) << 5); R = (st >> 1) * 16 + swz / 64; C = (st & 1) * 32 + (swz % 64) / 2; }
__host__ __device__ __forceinline__ int perm32(int rho) { const int n = rho >> 4, i = rho & 15; return 8 * (i >> 2) + 4 * n + (i & 3); }

struct Unit { int pm, pn; };
struct Gemm { const GAS bf16_t* A; const GAS bf16_t* Bt; int M, N, K; };

struct StaticOrder {
    int nM, nN, nwg, G, c;
    __device__ void init(int M_, int N_, int G_, int c_) { nM = M_ / BM; nN = N_ / BM; nwg = nM * nN; G = G_; c = c_; }
    __device__ bool next(int i, Unit& u) const {
        const long L = (long)i * G + c; if (L >= nwg) return false;
        int wgid = (int)L; { const int q = nwg / NXCD, r = nwg % NXCD, xcd = wgid % NXCD, off = wgid / NXCD; wgid = (xcd < r ? xcd * (q + 1) : r * (q + 1) + (xcd - r) * q) + off; }
        const int nig = WGM * nN, gid = wgid / nig, fm = gid * WGM, gsz = (nM - fm) < WGM ? (nM - fm) : WGM;
        u.pm = fm + ((wgid % nig) % gsz); u.pn = (wgid % nig) / gsz; return true;
    }
};


struct EpiQKV {
    static constexpr bool PERM = true;
    GAS bf16_t* O;
    const GAS float* gt; int normmask;
    GAS float* logf; const GAS float* bfg;
    const GAS float* ssq;
    LAS float* xch;
    __device__ __forceinline__ void operator()(const f32x4 (&acc)[2][2][4][2], const Unit& u, int wr, int wc, int fr, int fq) const {
        const int t = u.pn >> 3;
        const int row0 = u.pm * BM + wr * 64 + fr;
        if (t == 3) {
            if (wc == 0 && fq < 2) {
#pragma unroll
                for (int ai = 0; ai < 2; ++ai)
#pragma unroll
                    for (int m = 0; m < 4; ++m) { const int row = row0 + ai * HALF + m * 16; const int b = row >> 12, s = row & 4095;
#pragma unroll
                        for (int n = 0; n < 2; ++n)
#pragma unroll
                            for (int j = 0; j < 4; ++j) { const int c = 8 * fq + 4 * n + j; const float z = acc[ai][0][m][n][j] + bfg[c];
                                const float lf = fminf(z, 0.f) - __logf(1.f + __expf(-fabsf(z)));
                                logf[((size_t)(b * NH + c)) * SEQ + s] = lf; } }
            }
            return;
        }
        const GAS float* gp = gt + t * HD; const bool g = (normmask >> t) & 1;
        GAS bf16_t* base = O + (size_t)t * SEG;
        const int colt = (u.pn & 7) * BM + wc * 32 + 8 * fq;
        f32x4 gv0 = (f32x4){1.f, 1.f, 1.f, 1.f}, gv1 = gv0;
        if (g) {
#pragma unroll
            for (int ai = 0; ai < 2; ++ai)
#pragma unroll
                for (int m = 0; m < 4; ++m)
#pragma unroll
                    for (int bj = 0; bj < 2; ++bj) { const f32x4 a = acc[ai][bj][m][0], b = acc[ai][bj][m][1];
                        float s = (a[0] * a[0] + a[1] * a[1]) + (a[2] * a[2] + a[3] * a[3]) + (b[0] * b[0] + b[1] * b[1]) + (b[2] * b[2] + b[3] * b[3]);
                        s += __shfl_xor(s, 16); s += __shfl_xor(s, 32);
                        if (fq == 0) xch[((ai * HALF + wr * 64 + m * 16 + fr) * 2 + bj) * 4 + wc] = s; }
            LDS_WAIT(); __builtin_amdgcn_s_barrier(); asm volatile("" ::: "memory");
            int go = wc * 32 + 8 * fq; asm volatile("" : "+v"(go));
            gv0 = *(const GAS f32x4*)(gp + go); gv1 = *(const GAS f32x4*)(gp + go + 4);
        }
#pragma unroll
        for (int ai = 0; ai < 2; ++ai)
#pragma unroll
            for (int m = 0; m < 4; ++m) { GAS bf16_t* rowp = base + (size_t)(row0 + ai * HALF + m * 16) * DM + colt;
                float r0 = 1.f, r1 = 1.f, rw = 1.f, rw2 = 1.f;
                if (ssq) { const GAS f32x4* pp = (const GAS f32x4*)(ssq + (size_t)(row0 + ai * HALF + m * 16) * 8); const f32x4 p = pp[0], q = pp[1];
                    rw2 = 1.f / ((((p[0] + p[1]) + (p[2] + p[3])) + ((q[0] + q[1]) + (q[2] + q[3]))) * (1.f / DM) + EPS); rw = sqrtf(rw2); }
                if (g) { const LAS f32x4* pp = (const LAS f32x4*)(xch + ((ai * HALF + wr * 64 + m * 16 + fr) * 2) * 4); const f32x4 p = pp[0], q = pp[1];
                    r0 = rsqrtf(((p[0] + p[1]) + (p[2] + p[3])) * rw2 * (1.f / 128.f) + EPS); r1 = rsqrtf(((q[0] + q[1]) + (q[2] + q[3])) * rw2 * (1.f / 128.f) + EPS); }
                r0 *= rw; r1 *= rw;
#pragma unroll
                for (int bj = 0; bj < 2; ++bj) { const float rr = bj ? r1 : r0; const f32x4 v0 = acc[ai][bj][m][0] * rr * gv0, v1 = acc[ai][bj][m][1] * rr * gv1;
                    u32x4 w; w.x = cvt_pk_bf16(v0[0], v0[1]); w.y = cvt_pk_bf16(v0[2], v0[3]); w.z = cvt_pk_bf16(v1[0], v1[1]); w.w = cvt_pk_bf16(v1[2], v1[3]);
                    *(GAS u32x4*)(rowp + bj * HALF) = w; }
                asm volatile("" ::: "memory"); }
    }
};
struct EpiResid {
    static constexpr bool PERM = false;
    const GAS float* xf; const GAS bf16_t* hin; GAS float* outf; GAS bf16_t* hb; GAS float* ssq;
    LAS float* xch;
    __device__ __forceinline__ void operator()(const f32x4 (&acc)[2][2][4][2], const Unit& u, int wr, int wc, int fr, int fq) const {
        const int row0 = u.pm * BM + wr * 64 + fr, col0 = u.pn * BM + wc * 32 + 4 * fq;
#pragma unroll
        for (int ai = 0; ai < 2; ++ai)
#pragma unroll
            for (int m = 0; m < 4; ++m) { const int row = row0 + ai * HALF + m * 16; const size_t off = (size_t)row * DM + col0;
                f32x4 bs[2][2];
                if (xf) {
#pragma unroll
                    for (int bj = 0; bj < 2; ++bj)
#pragma unroll
                        for (int n = 0; n < 2; ++n) bs[bj][n] = *(const GAS f32x4*)(xf + off + bj * HALF + n * 16);
                } else {
                    u32x2 hw[2][2];
#pragma unroll
                    for (int bj = 0; bj < 2; ++bj)
#pragma unroll
                        for (int n = 0; n < 2; ++n) hw[bj][n] = *(const GAS u32x2*)(hin + off + bj * HALF + n * 16);
#pragma unroll
                    for (int bj = 0; bj < 2; ++bj)
#pragma unroll
                        for (int n = 0; n < 2; ++n) { const u32x2 w = hw[bj][n];
                            bs[bj][n] = (f32x4){__uint_as_float(w.x << 16), __uint_as_float(w.x & 0xffff0000u), __uint_as_float(w.y << 16), __uint_as_float(w.y & 0xffff0000u)}; }
                }
                float sq = 0.f;
#pragma unroll
                for (int bj = 0; bj < 2; ++bj)
#pragma unroll
                    for (int n = 0; n < 2; ++n) { const f32x4 v = acc[ai][bj][m][n] + bs[bj][n];
                        if (outf) *(GAS f32x4*)(outf + off + bj * HALF + n * 16) = v;
                        if (hb) { u32x2 w; w.x = cvt_pk_bf16(v[0], v[1]); w.y = cvt_pk_bf16(v[2], v[3]); *(GAS u32x2*)(hb + off + bj * HALF + n * 16) = w;
                            sq += (v[0] * v[0] + v[1] * v[1]) + (v[2] * v[2] + v[3] * v[3]); } }
                if (hb) { sq += __shfl_xor(sq, 16); sq += __shfl_xor(sq, 32); if (fq == 0) xch[(ai * HALF + wr * 64 + m * 16 + fr) * 4 + wc] = sq; }
                asm volatile("" ::: "memory"); }
        if (hb) { LDS_WAIT(); __builtin_amdgcn_s_barrier(); asm volatile("" ::: "memory");
            const int t = wr * 256 + wc * 64 + fq * 16 + fr;
            if (t < 256) { const f32x4 p = *(const LAS f32x4*)(xch + t * 4); ssq[(size_t)(u.pm * BM + t) * 8 + u.pn] = (p[0] + p[1]) + (p[2] + p[3]); } }
    }
};
struct EpiRelu2 {
    static constexpr bool PERM = true;
    GAS bf16_t* O; const GAS float* ssq;
    __device__ __forceinline__ void operator()(const f32x4 (&acc)[2][2][4][2], const Unit& u, int wr, int wc, int fr, int fq) const {
        const int row0 = u.pm * BM + wr * 64 + fr, col0 = u.pn * BM + wc * 32 + 8 * fq;
#pragma unroll
        for (int ai = 0; ai < 2; ++ai)
#pragma unroll
            for (int m = 0; m < 4; ++m) { GAS bf16_t* rowp = O + (size_t)(row0 + ai * HALF + m * 16) * FF + col0;
                float r2; { const GAS f32x4* pp = (const GAS f32x4*)(ssq + (size_t)(row0 + ai * HALF + m * 16) * 8); const f32x4 p = pp[0], q = pp[1];
                    r2 = 1.f / ((((p[0] + p[1]) + (p[2] + p[3])) + ((q[0] + q[1]) + (q[2] + q[3]))) * (1.f / DM) + EPS); }
#pragma unroll
                for (int bj = 0; bj < 2; ++bj) { f32x4 v0 = acc[ai][bj][m][0], v1 = acc[ai][bj][m][1];
#pragma unroll
                    for (int j = 0; j < 4; ++j) { v0[j] = fmaxf(v0[j], 0.f); v1[j] = fmaxf(v1[j], 0.f); }
                    v0 = v0 * v0 * r2; v1 = v1 * v1 * r2;
                    u32x4 w; w.x = cvt_pk_bf16(v0[0], v0[1]); w.y = cvt_pk_bf16(v0[2], v0[3]); w.z = cvt_pk_bf16(v1[0], v1[1]); w.w = cvt_pk_bf16(v1[2], v1[3]);
                    *(GAS u32x4*)(rowp + bj * HALF) = w; } }
    }
};

template <class Epi>
__device__ __forceinline__ void gemm_phase(LAS unsigned char* lds, Gemm g, const StaticOrder& S, const Epi& E) {
    int tid = threadIdx.x; asm volatile("" : "+v"(tid));
    asm volatile("" : "+s"(g.A), "+s"(g.Bt));
    const int wid = __builtin_amdgcn_readfirstlane(tid >> 6), lane = tid & 63, wr = wid >> 2, wc = wid & 3, fr = lane & 15, fq = lane >> 4;
    const int K = g.K, nt = K / BK;
    unsigned voffA[2], voffB[2];
#pragma unroll
    for (int i = 0; i < 2; ++i) { int R, C; stage_rc(tid * 16 + i * 8192, R, C); const int Rb = Epi::PERM ? ((R & ~31) + perm32(R & 31)) : R;
        voffA[i] = (unsigned)(R * K + C) * 2u; voffB[i] = (unsigned)(Rb * K + C) * 2u; }
    const size_t kstep = (size_t)(BK * 2);
    const size_t hstep = (size_t)HALF * K * 2;
    const size_t tstep = 2 * hstep;
    const unsigned ldsw = (unsigned)wid * 1024u;
    const int aoff = lds_byte(wr * 64 + fr, fq * 8), boff = lds_byte(wc * 32 + fr, fq * 8);
#define PG8_SA(b, h) (((b) * 2 + (h)) * HTB)
#define PG8_SB(b, h) ((4 + (b) * 2 + (h)) * HTB)
#define PG8_STAGE(bufoff, gbase, voff) do { _Pragma("unroll") for (int _i = 0; _i < 2; ++_i) \
        __builtin_amdgcn_global_load_lds((const GAS unsigned*)((const GAS char*)(gbase) + (voff)[_i]), (LAS unsigned*)(lds + (bufoff) + ldsw + _i * 8192), 16, 0, 0); } while (0)
#define PG8_LDA(dst, b, h) do { _Pragma("unroll") for (int m = 0; m < 4; ++m) _Pragma("unroll") for (int k = 0; k < 2; ++k) dst[m][k] = *(const LAS bf16x8*)(lds + PG8_SA(b, h) + aoff + m * 2048 + k * 1024); } while (0)
#define PG8_LDB(dst, b, h) do { _Pragma("unroll") for (int n = 0; n < 2; ++n) _Pragma("unroll") for (int k = 0; k < 2; ++k) dst[n][k] = *(const LAS bf16x8*)(lds + PG8_SB(b, h) + boff + n * 2048 + k * 1024); } while (0)
#define PG8_MMA(ai, bj, At, Bt) do { __builtin_amdgcn_s_setprio(1); _Pragma("unroll") for (int m = 0; m < 4; ++m) _Pragma("unroll") for (int n = 0; n < 2; ++n) _Pragma("unroll") for (int k = 0; k < 2; ++k) \
        acc[ai][bj][m][n] = __builtin_amdgcn_mfma_f32_16x16x32_bf16(Bt[n][k], At[m][k], acc[ai][bj][m][n], 0, 0, 0); __builtin_amdgcn_s_setprio(0); } while (0)
#define PG8_WAIT_V(n) asm volatile("s_waitcnt vmcnt(" #n ")" ::: "memory")
#define PG8_WAIT_L(n) asm volatile("s_waitcnt lgkmcnt(" #n ")" ::: "memory")
#define PG8_BAR __builtin_amdgcn_s_barrier()
#define PG8_SCHED __builtin_amdgcn_sched_barrier(0)
    Unit cur, nxt; int ui = 0;
    if (!S.next(0, cur)) return;
    f32x4 acc[2][2][4][2];
#pragma unroll
    for (int a = 0; a < 2; ++a)
#pragma unroll
        for (int b = 0; b < 2; ++b)
#pragma unroll
            for (int m = 0; m < 4; ++m)
#pragma unroll
                for (int n = 0; n < 2; ++n) acc[a][b][m][n] = (f32x4){0.f, 0.f, 0.f, 0.f};
    bf16x8 At[4][2], B0[2][2], B1[2][2];
    const GAS char* cA = (const GAS char*)g.A + (size_t)cur.pm * tstep; const GAS char* cB = (const GAS char*)g.Bt + (size_t)cur.pn * tstep;
    PG8_STAGE(PG8_SB(0, 0), cB, voffB); PG8_STAGE(PG8_SB(0, 1), cB + hstep, voffB); PG8_STAGE(PG8_SA(0, 0), cA, voffA); PG8_STAGE(PG8_SA(0, 1), cA + hstep, voffA);
    if (wr == 1) PG8_BAR;
    PG8_WAIT_V(2); PG8_BAR;
    PG8_STAGE(PG8_SB(1, 0), cB + kstep, voffB); PG8_STAGE(PG8_SA(1, 0), cA + kstep, voffA); PG8_STAGE(PG8_SB(1, 1), cB + hstep + kstep, voffB);
    PG8_WAIT_V(6); PG8_BAR;
    for (;;) {
        const bool has_next = S.next(ui + 1, nxt);
        const GAS char* nA = has_next ? (const GAS char*)g.A + (size_t)nxt.pm * tstep : cA; const GAS char* nB = has_next ? (const GAS char*)g.Bt + (size_t)nxt.pn * tstep : cB;
        for (int t = 0; t < nt; t += 2) {
            const bool last = (t == nt - 2);
            const GAS char* a1 = cA + (size_t)(t + 1) * kstep;
            const GAS char* a2 = last ? nA : cA + (size_t)(t + 2) * kstep; const GAS char* b2 = last ? nB : cB + (size_t)(t + 2) * kstep;
            const GAS char* a3 = a2 + kstep; const GAS char* b3 = b2 + kstep;
            PG8_LDB(B0, 0, 0); PG8_LDB(B1, 0, 1); PG8_SCHED; PG8_LDA(At, 0, 0); PG8_STAGE(PG8_SA(1, 1), a1 + hstep, voffA);
            PG8_WAIT_V(8); PG8_WAIT_L(0); PG8_BAR; PG8_MMA(0, 0, At, B0); PG8_MMA(0, 1, At, B1); PG8_BAR; PG8_SCHED;
            PG8_LDA(At, 0, 1); PG8_STAGE(PG8_SB(0, 0), b2, voffB); PG8_STAGE(PG8_SB(0, 1), b2 + hstep, voffB); PG8_STAGE(PG8_SA(0, 0), a2, voffA);
            PG8_WAIT_V(8); PG8_WAIT_L(0); PG8_BAR; PG8_MMA(1, 0, At, B0); PG8_MMA(1, 1, At, B1); PG8_BAR; PG8_SCHED;
            PG8_LDB(B0, 1, 0); PG8_LDB(B1, 1, 1); PG8_SCHED; PG8_LDA(At, 1, 0); PG8_STAGE(PG8_SA(0, 1), a2 + hstep, voffA);
            PG8_WAIT_V(8); PG8_WAIT_L(0); PG8_BAR; PG8_MMA(0, 0, At, B0); PG8_MMA(0, 1, At, B1); PG8_BAR; PG8_SCHED;
            PG8_LDA(At, 1, 1); PG8_STAGE(PG8_SB(1, 0), b3, voffB); PG8_STAGE(PG8_SB(1, 1), b3 + hstep, voffB); PG8_STAGE(PG8_SA(1, 0), a3, voffA);
            PG8_WAIT_V(8); PG8_WAIT_L(0); PG8_BAR; PG8_MMA(1, 0, At, B0); PG8_MMA(1, 1, At, B1); PG8_BAR; PG8_SCHED;
        }
        if (wr == 0) PG8_BAR;
        E(acc, cur, wr, wc, fr, fq);
        if (!has_next) break;
#pragma unroll
        for (int a = 0; a < 2; ++a)
#pragma unroll
            for (int b = 0; b < 2; ++b)
#pragma unroll
                for (int m = 0; m < 4; ++m)
#pragma unroll
                    for (int n = 0; n < 2; ++n) acc[a][b][m][n] = (f32x4){0.f, 0.f, 0.f, 0.f};
        cur = nxt; cA = nA; cB = nB; ++ui;
        if (wr == 1) PG8_BAR;
    }
    PG8_WAIT_V(0);
    PG8_BAR;
#undef PG8_SA
#undef PG8_SB
#undef PG8_STAGE
#undef PG8_LDA
#undef PG8_LDB
#undef PG8_MMA
#undef PG8_WAIT_V
#undef PG8_WAIT_L
#undef PG8_BAR
#undef PG8_SCHED
}
}

namespace att {
constexpr int D = 128, RS = 2048, NW = 8, QBLK = 32, KVBLK = 64, QB = NW * QBLK;
constexpr int SHM_V = KVBLK * D * 2, SHM_K = KVBLK * D * 2;
constexpr int OFF_WS = 2 * SHM_V + 2 * SHM_K;
constexpr int OFF_BIAS = OFF_WS + NW * 64 * 4;
constexpr int CST = 648;
constexpr float THR = 8.f;

#define KSWZ(row, colB) ((row) * 256 + ((colB) ^ (((row) & 7) << 4)))
#define SBAR() __builtin_amdgcn_sched_barrier(0)
__device__ __forceinline__ int v_st(int k, int c) { const int kk = (k & ~0xC) | ((k & 4) << 1) | ((k & 8) >> 1); return ((kk >> 3) * 4 + (c >> 5)) * 512 + ((kk & 7) * 32 + (c & 31)) * 2; }
__device__ __forceinline__ int v_rd_base(int lane) { return ((lane & 3) << 3) | (((lane >> 2) & 3) << 6) | (((lane >> 4) & 1) << 5) | (((lane >> 5) & 1) << 8); }
constexpr int v_rd_off(int d0, int ks, int half) { return d0 * 512 + ks * 4096 + half * 2048; }
__device__ __forceinline__ int crow(int r, int hi) { return (r & 3) + 8 * (r >> 2) + 4 * hi; }
__device__ __forceinline__ unsigned cvtpk(float lo, float hi) { unsigned r; asm volatile("v_cvt_pk_bf16_f32 %0, %1, %2" : "=v"(r) : "v"(lo), "v"(hi)); return r; }
__device__ __forceinline__ bf16x8 load8(const GAS bf16_t* p) { return *(const GAS bf16x8*)(p); }

__device__ __forceinline__ void mask_tile(f32x16& p0, f32x16& p1, int dq, unsigned W) {
    const float NEG = -__builtin_inff();
#pragma unroll
    for (int r = 0; r < 16; ++r) {
        const int c = (r & 3) + 8 * (r >> 2);
        if ((unsigned)(dq - c) >= W) p0[r] = NEG;
        if ((unsigned)(dq - c - 32) >= W) p1[r] = NEG;
    }
}
__device__ __forceinline__ void partialSM(f32x16& p0, f32x16& p1, float& m_reg, float& mn, float& alpha) {
    float pmax = p0[0];
#pragma unroll
    for (int r = 1; r < 16; ++r) pmax = fmaxf(pmax, p0[r]);
#pragma unroll
    for (int r = 0; r < 16; ++r) pmax = fmaxf(pmax, p1[r]);
    { auto rr = __builtin_amdgcn_permlane32_swap(__float_as_uint(pmax), __float_as_uint(pmax), false, false);
      pmax = fmaxf(__uint_as_float(rr[0]), __uint_as_float(rr[1])); }
    constexpr float C2 = 1.4426950408889634f * SCALE;
    if (__builtin_expect(__all((pmax - m_reg) * SCALE <= THR), 1)) { mn = m_reg; alpha = 1.f; }
    else { mn = fmaxf(m_reg, pmax); alpha = __builtin_amdgcn_exp2f((m_reg - mn) * C2); m_reg = mn; }
    const float mnL = -mn * C2;
#pragma unroll
    for (int r = 0; r < 16; ++r) p0[r] = fmaf(p0[r], C2, mnL);
#pragma unroll
    for (int r = 0; r < 16; ++r) p1[r] = fmaf(p1[r], C2, mnL);
#pragma unroll
    for (int r = 0; r < 16; ++r) p0[r] = __builtin_amdgcn_exp2f(p0[r]);
}
__device__ __forceinline__ void finishSM(f32x16& p0, f32x16& p1, float alpha, float& l_reg, bf16x8& pa0, bf16x8& pa1, bf16x8& pa2, bf16x8& pa3) {
#pragma unroll
    for (int r = 0; r < 16; ++r) p1[r] = __builtin_amdgcn_exp2f(p1[r]);
    float ps = 0;
#pragma unroll
    for (int r = 0; r < 16; ++r) ps += p0[r];
#pragma unroll
    for (int r = 0; r < 16; ++r) ps += p1[r];
    { auto rr = __builtin_amdgcn_permlane32_swap(__float_as_uint(ps), __float_as_uint(ps), false, false);
      ps = __uint_as_float(rr[0]) + __uint_as_float(rr[1]); }
    l_reg = l_reg * alpha + ps;
#define PK4(P, B_, OUT) do { unsigned a0 = cvtpk(P[B_+0], P[B_+1]), a1 = cvtpk(P[B_+2], P[B_+3]);                          \
        unsigned b0 = cvtpk(P[B_+4], P[B_+5]), b1 = cvtpk(P[B_+6], P[B_+7]);                                             \
        auto r0 = __builtin_amdgcn_permlane32_swap(a0, b0, false, false); auto r1 = __builtin_amdgcn_permlane32_swap(a1, b1, false, false); \
        u32x4 w = {r0[0], r1[0], r0[1], r1[1]}; OUT = *reinterpret_cast<bf16x8*>(&w); } while (0)
    PK4(p0, 0, pa0); PK4(p0, 8, pa1); PK4(p1, 0, pa2); PK4(p1, 8, pa3);
#undef PK4
}
template <int KB, bool SK>
__device__ __forceinline__ void qkt(f32x16& p0, f32x16& p1, const char* K_lds, int r32, int hi, const bf16x8* qr, bool act, const char* bp) {
    if (SK && !act) { const float NEG = -__builtin_inff();
#pragma unroll
        for (int r = 0; r < 16; ++r) { p0[r] = NEG; p1[r] = NEG; } return; }
    { const f32x4 b0 = *(const f32x4*)(bp), b1 = *(const f32x4*)(bp + 32), b2 = *(const f32x4*)(bp + 64), b3 = *(const f32x4*)(bp + 96);
      const f32x4 b4 = *(const f32x4*)(bp + 128), b5 = *(const f32x4*)(bp + 160), b6 = *(const f32x4*)(bp + 192), b7 = *(const f32x4*)(bp + 224);
      p0 = (f32x16){b0[0], b0[1], b0[2], b0[3], b1[0], b1[1], b1[2], b1[3], b2[0], b2[1], b2[2], b2[3], b3[0], b3[1], b3[2], b3[3]};
      p1 = (f32x16){b4[0], b4[1], b4[2], b4[3], b5[0], b5[1], b5[2], b5[3], b6[0], b6[1], b6[2], b6[3], b7[0], b7[1], b7[2], b7[3]}; }
    const char* kb[4];
#pragma unroll
    for (int dd = 0; dd < 4; ++dd) kb[dd] = K_lds + KB * SHM_K + KSWZ(r32, (dd * 16 + hi * 8) * 2);
#pragma unroll
    for (int d0 = 0; d0 < 8; ++d0) { const char* a = kb[d0 & 3] + (d0 >> 2) * 128;
        bf16x8 b0 = *reinterpret_cast<const bf16x8*>(a);
        bf16x8 b1 = *reinterpret_cast<const bf16x8*>(a + 32 * 256);
        p0 = __builtin_amdgcn_mfma_f32_32x32x16_bf16(b0, qr[d0], p0, 0, 0, 0);
        p1 = __builtin_amdgcn_mfma_f32_32x32x16_bf16(b1, qr[d0], p1, 0, 0, 0); }
}
template <int VB, bool SK>
__device__ __forceinline__ void pv_tile(f32x16* o, int vb0, bf16x8 pa0, bf16x8 pa1, bf16x8 pa2, bf16x8 pa3, bool act) {
    if (SK && !act) return;
#define TRRD(dst, off) asm volatile("ds_read_b64_tr_b16 %0, %1 offset:%2" : "=&v"(dst) : "v"(vb0), "i"(off) : "memory")
#define PV_D0(d0) do { s16x4 l0, l1, l2, l3, h0, h1, h2, h3; constexpr int b_ = VB * SHM_V + v_rd_off(d0, 0, 0); \
        TRRD(l0, b_); TRRD(h0, b_ + 2048); TRRD(l1, b_ + 4096); TRRD(h1, b_ + 6144); TRRD(l2, b_ + 8192); TRRD(h2, b_ + 10240); TRRD(l3, b_ + 12288); TRRD(h3, b_ + 14336); \
        asm volatile("s_waitcnt lgkmcnt(0)" ::: "memory"); SBAR();   \
        o[d0] = __builtin_amdgcn_mfma_f32_32x32x16_bf16(pa0, (bf16x8){l0[0], l0[1], l0[2], l0[3], h0[0], h0[1], h0[2], h0[3]}, o[d0], 0, 0, 0);   \
        o[d0] = __builtin_amdgcn_mfma_f32_32x32x16_bf16(pa1, (bf16x8){l1[0], l1[1], l1[2], l1[3], h1[0], h1[1], h1[2], h1[3]}, o[d0], 0, 0, 0);   \
        o[d0] = __builtin_amdgcn_mfma_f32_32x32x16_bf16(pa2, (bf16x8){l2[0], l2[1], l2[2], l2[3], h2[0], h2[1], h2[2], h2[3]}, o[d0], 0, 0, 0);   \
        o[d0] = __builtin_amdgcn_mfma_f32_32x32x16_bf16(pa3, (bf16x8){l3[0], l3[1], l3[2], l3[3], h3[0], h3[1], h3[2], h3[3]}, o[d0], 0, 0, 0); } while (0)
    PV_D0(0); PV_D0(1); PV_D0(2); PV_D0(3);
#undef PV_D0
#undef TRRD
}

struct BlockRef { const GAS bf16_t* Q; const GAS bf16_t* K; const GAS bf16_t* V; GAS bf16_t* O; const GAS float* bt; int P0; int jl; };
struct Seam { bf16x8 qr[8]; bf16x8 st_v0, st_v1, st_k0, st_k1; };

#define ROW(p, k0, rr) ((p) + (size_t)((k0) + (rr)) * RS + sc)
#define VMW() asm volatile("s_waitcnt vmcnt(0)" ::: "memory")
#define VMWN(n) asm volatile("s_waitcnt vmcnt(%0)" :: "i"(n) : "memory")
#define SLOAD_H(Kp, Vp, k0) do { S.st_v0 = load8(ROW(Vp, k0, sr)); S.st_v1 = load8(ROW(Vp, k0, 32 + sr));              \
                         S.st_k0 = load8(ROW(Kp, k0, sr)); S.st_k1 = load8(ROW(Kp, k0, 32 + sr)); } while (0)
#define SWRITE_HK(bf) do { *(bf16x8*)(K_lds + (bf) * SHM_K + kws) = S.st_k0; *(bf16x8*)(K_lds + (bf) * SHM_K + kws + 32 * 256) = S.st_k1; } while (0)
#define SWRITE_HV(bf) do { *(bf16x8*)(V_lds + (bf) * SHM_V + vst0) = S.st_v0; *(bf16x8*)(V_lds + (bf) * SHM_V + vst1) = S.st_v1; } while (0)
#define SWRITE_H(bf) do { SWRITE_HV(bf); SWRITE_HK(bf); } while (0)

template <int MODE>
__device__ __forceinline__ void attn_prime(const BlockRef& cur, char* lds, Seam& S) {
    int tid = threadIdx.x; asm volatile("" : "+v"(tid));
    const int wid = __builtin_amdgcn_readfirstlane(tid >> 6), lane = tid & 63, r32 = lane & 31, hi = lane >> 5;
    const int sr = tid >> 4, sc = (tid & 15) * 8, kws = KSWZ(sr, sc * 2); char* K_lds = lds + 2 * SHM_V;
    const int kb0 = cur.jl * KVBLK;
#pragma unroll
    for (int d0 = 0; d0 < 8; ++d0) S.qr[d0] = load8(cur.Q + (size_t)(wid * QBLK + r32) * RS + d0 * 16 + hi * 8);
    SLOAD_H(cur.K, cur.V, kb0); VMW(); SWRITE_HK(0);
    __syncthreads();
}
template <int MODE>
__device__ __forceinline__ void attn_block(const BlockRef& cur, const BlockRef& nxt, char* lds, Seam& S) {
    constexpr bool SK = false;
    int tid = threadIdx.x; asm volatile("" : "+v"(tid));
    const int wid = __builtin_amdgcn_readfirstlane(tid >> 6), lane = tid & 63, r32 = lane & 31, hi = lane >> 5;
    const int j_lo = cur.jl;
    const int j_hi = (cur.P0 >> 6) + 4;
    const int NT = j_hi - j_lo;
    const int kbn = nxt.jl * KVBLK;
    const int qlo = cur.P0 + wid * QBLK, qm = qlo + r32 - 4 * hi;
    const int cw = (cur.P0 >> 6) + (wid >> 1);
    char* V_lds = lds; char* K_lds = lds + 2 * SHM_V;
    float* ws = (float*)(lds + OFF_WS) + wid * 64; float* li_l = ws, * al_l = ws + 32;
    { float* tab = (float*)(lds + OFF_BIAS);
      if (MODE == 0) { const float cref = cur.bt[cur.P0]; const int nk = cur.P0 + QB;
          _Pragma("clang loop vectorize(disable) unroll(disable)") for (int i = j_lo * KVBLK + tid; i < nk; i += NW * 64) tab[i] = (cref - cur.bt[i]) * RSC; }
      else { _Pragma("clang loop vectorize(disable) unroll(disable)") for (int i = tid; i < 4 * CST; i += NW * 64) { const int a = i / CST, j = i - a * CST + a; int dist = 575 - j; dist = dist < -63 ? -63 : (dist > 256 ? 256 : dist);
                 tab[i] = cur.bt[dist + 63] * RSC; } }
      __syncthreads(); }
    int bl;
    if (MODE == 0) bl = OFF_BIAS + 16 * hi;
    else { const int tpos = cur.P0 + wid * QBLK + r32; const int a = (575 - tpos) & 3; bl = OFF_BIAS + a * (CST * 4) + 4 * (575 - tpos - a + 4 * hi); }
    asm volatile("" : "+v"(bl));
    float m_reg = -1e30f, l_reg = 0; f32x16 o[4] = {};
    const int sr = tid >> 4, sc = (tid & 15) * 8, vst0 = v_st(sr, sc), vst1 = v_st(32 + sr, sc), kws = KSWZ(sr, sc * 2);
    const int vb0 = (int)(uintptr_t)V_lds + v_rd_base(lane);
    const GAS bf16_t* Kh = cur.K; const GAS bf16_t* Vh = cur.V;
#define RESC(a) do { if (__any((a) < 1.f)) { if (hi == 0) al_l[r32] = (a); asm volatile("s_waitcnt lgkmcnt(0)" ::: "memory");              \
                     for (int d_ = 0; d_ < 4; ++d_) for (int r = 0; r < 16; ++r) o[d_][r] *= al_l[crow(r, hi)]; } } while (0)
#define KBASE(t) ((j_lo + (t)) * KVBLK)
#define BP(t) (lds + (bl + ((MODE == 0 || ACT(t)) ? KBASE(t) : cw * KVBLK) * 4))
#define ACT(t) (MODE == 0 ? true : ((j_lo + (t)) <= cw && (j_lo + (t)) >= cw - 8))
#define MASKT(P0_, P1_, t) do { if (MODE == 0) { const int kb_ = KBASE(t); if (kb_ + KVBLK - 1 > qlo) mask_tile(P0_, P1_, qm - kb_, 0x7fffffffu); } \
        else if (!ACT(t)) { const float NEG_ = -__builtin_inff(); _Pragma("unroll") for (int r_ = 0; r_ < 16; ++r_) { P0_[r_] = NEG_; P1_[r_] = NEG_; } } } while (0)
    constexpr int NQL = 8;
#define SEAM_K0() do { VMWN(NQL); SWRITE_HK(0); SBAR(); } while (0)
    f32x16 pA0, pA1, pB0, pB1; float mnA, mnB, alA, alB; bf16x8 pa0, pa1, pa2, pa3;
    SWRITE_HV(0); SBAR();
    if (NT > 1) { SLOAD_H(Kh, Vh, KBASE(1)); }
    SBAR(); qkt<0, SK>(pA0, pA1, K_lds, r32, hi, S.qr, ACT(0), BP(0));
    MASKT(pA0, pA1, 0); partialSM(pA0, pA1, m_reg, mnA, alA);
    if (NT > 1) { VMW(); SWRITE_H(1); }
    __syncthreads();
#define HALF_STEP(PX0, PX1, mnX, alX, PY0, PY1, alY, t, KB, VB, SB) do {                                                      \
        SBAR(); qkt<KB, SK>(PX0, PX1, K_lds, r32, hi, S.qr, ACT(t), BP(t));                                      \
        finishSM(PY0, PY1, alY, l_reg, pa0, pa1, pa2, pa3); SBAR();                                                           \
        if ((t) + 1 < NT) { SLOAD_H(Kh, Vh, KBASE((t) + 1)); SBAR(); }                                                        \
        pv_tile<VB, SK>(o, vb0, pa0, pa1, pa2, pa3, ACT((t) - 1)); MASKT(PX0, PX1, (t)); partialSM(PX0, PX1, m_reg, mnX, alX); \
        __syncthreads();                                                                                                      \
        if ((t) + 1 < NT) { VMW(); SWRITE_H(SB); }                                                                            \
        RESC(alX); __syncthreads(); } while (0)
    for (int t = 1; t + 1 < NT; t += 2) {
        HALF_STEP(pB0, pB1, mnB, alB, pA0, pA1, alA, t, 1, 0, 0);
        HALF_STEP(pA0, pA1, mnA, alA, pB0, pB1, alB, t + 1, 0, 1, 1);
    }
    const bool even = (NT & 1) == 0;
    if (even) { SBAR(); qkt<1, SK>(pB0, pB1, K_lds, r32, hi, S.qr, ACT(NT - 1), BP(NT - 1)); SBAR(); }
    SLOAD_H(nxt.K, nxt.V, kbn); SBAR();
#pragma unroll
    for (int d0 = 0; d0 < 8; ++d0) S.qr[d0] = load8(nxt.Q + (size_t)(wid * QBLK + r32) * RS + d0 * 16 + hi * 8);
    SBAR();
    finishSM(pA0, pA1, alA, l_reg, pa0, pa1, pa2, pa3); SBAR();
    pv_tile<0, SK>(o, vb0, pa0, pa1, pa2, pa3, ACT(even ? NT - 2 : NT - 1));
    if (even) { MASKT(pB0, pB1, NT - 1); partialSM(pB0, pB1, m_reg, mnB, alB); __syncthreads(); RESC(alB);
        finishSM(pB0, pB1, alB, l_reg, pa0, pa1, pa2, pa3); SBAR(); pv_tile<1, SK>(o, vb0, pa0, pa1, pa2, pa3, ACT(NT - 1)); }
    SBAR(); SEAM_K0();
    if (hi == 0) li_l[r32] = l_reg; asm volatile("s_waitcnt lgkmcnt(0)" ::: "memory");
    float rli[16];
#pragma unroll
    for (int r = 0; r < 16; ++r) rli[r] = __builtin_amdgcn_rcpf(li_l[crow(r, hi)]);
    GAS bf16_t* Ow = cur.O + (size_t)(wid * QBLK) * RS;
#pragma unroll
    for (int r = 0; r < 16; ++r) { const int orow = crow(r, hi);
#pragma unroll
        for (int d0 = 0; d0 < 4; ++d0) { const float v = o[d0][r] * rli[r];
            const float vn = __shfl_xor(v, 1);
            if ((r32 & 1) == 0) *(GAS unsigned*)(Ow + (size_t)orow * RS + d0 * 32 + r32) = cvtpk(v, vn); } }
    __syncthreads();
#undef RESC
#undef KBASE
#undef BP
#undef ACT
#undef MASKT
#undef SEAM_K0
#undef HALF_STEP
}
#undef ROW
#undef VMW
#undef VMWN
#undef SLOAD_H
#undef SWRITE_HK
#undef SWRITE_HV
#undef SWRITE_H

template <int MODE>
__device__ __forceinline__ BlockRef block_ref(int n, int vcu, int G, const GAS bf16_t* Q, const GAS bf16_t* K, const GAS bf16_t* V, GAS bf16_t* O, const GAS float* bt, const GAS int* jtab) {
    int bh, qb;
    if (MODE == 0) {
        if (G == 2 * BATCH * NH) { bh = vcu >> 1; const int p = n >> 1; qb = (vcu & 1) ? ((n & 1) ? 13 - 4 * p : 14 - 4 * p) : ((n & 1) ? 12 - 4 * p : 15 - 4 * p); }
        else { const int L = vcu + n * G; bh = L >> 4; qb = 15 - (L & 15); }
    } else { const int L = vcu + n * G; bh = L >> 4; qb = L & 15; }
    const int b = bh >> 4, h = bh & 15;
    BlockRef r; const size_t row0 = (size_t)b * SEQ;
    r.Q = Q + (row0 + (size_t)qb * QB) * RS + h * D; r.O = O + (row0 + (size_t)qb * QB) * RS + h * D;
    r.K = K + row0 * RS + h * D; r.V = V + row0 * RS + h * D; r.P0 = qb * QB;
    r.bt = MODE == 0 ? bt + (size_t)bh * SEQ : bt + h * NREL;
    if (MODE == 0) r.jl = jtab[bh * 16 + qb]; else { const int j = (r.P0 >> 6) - 8; r.jl = j > 0 ? j : 0; }
    return r;
}
template <int MODE>
__device__ __forceinline__ void attn_phase(char* lds, int vcu, int G, const GAS bf16_t* Q, const GAS bf16_t* K, const GAS bf16_t* V, GAS bf16_t* O, const GAS float* bt, const GAS int* jtab) {
    asm volatile("" : "+s"(Q), "+s"(K), "+s"(V), "+s"(O), "+s"(bt), "+s"(vcu), "+s"(jtab));
    const int total = BATCH * NH * 16;
    int nblk = 0; for (int L = vcu; L < total; L += G) ++nblk;
    if (nblk == 0) return;
    BlockRef cur = block_ref<MODE>(0, vcu, G, Q, K, V, O, bt, jtab);
    Seam S;
    attn_prime<MODE>(cur, lds, S);
    for (int n = 0; n < nblk; ++n) {
        const bool last = (n + 1 == nblk);
        const BlockRef nxt = last ? cur : block_ref<MODE>(n + 1, vcu, G, Q, K, V, O, bt, jtab);
        attn_block<MODE>(cur, nxt, lds, S);
        cur = nxt;
    }
}
}


#define XB_TMO      128
#define XB_XCNT(j)  (256  + 64 * (j))
#define XB_XSUB(j)  (1280 + 64 * (j))
#define XB_XGEN(j)  (2304 + 64 * (j))
#define XB_TOP      3328
#define XB_TOPGEN   3392
#define XCD_BAR_WORDS 3456
#define XB_SPIN_CAP (1u << 18)
__device__ __forceinline__ unsigned xb_ld(unsigned* p)              { return __hip_atomic_load(p, __ATOMIC_RELAXED, __HIP_MEMORY_SCOPE_AGENT); }
__device__ __forceinline__ unsigned xb_add(unsigned* p, unsigned v) { return __hip_atomic_fetch_add(p, v, __ATOMIC_RELAXED, __HIP_MEMORY_SCOPE_AGENT); }
__device__ __forceinline__ unsigned xb_xcc_id() { return (unsigned)__builtin_amdgcn_s_getreg((3 << 11) | 20) & 0xFu; }
#define XB_SPIN(cond, bar) do { unsigned _sp = 0; while (cond) { __builtin_amdgcn_s_sleep(1); \
    if ((++_sp & 255u) == 0u) { if (xb_ld(&(bar)[XB_TMO])) break; if (_sp > XB_SPIN_CAP) { atomicAdd(&(bar)[XB_TMO], 1u); break; } } } } while (0)
struct XcdBarrier { unsigned* bar; unsigned x; volatile LAS unsigned* st; };
__device__ __forceinline__ XcdBarrier xcd_barrier_post(unsigned* bar, volatile LAS unsigned* st) {
    XcdBarrier b; b.bar = bar; b.x = xb_xcc_id(); b.st = st;
    if (threadIdx.x == 0) (void)xb_add(&bar[XB_XCNT(b.x)], 1u);
    return b;
}
__device__ __forceinline__ void xcd_barrier_complete(unsigned* bar, unsigned x, unsigned& nloc, unsigned& nx) {
    const unsigned G = gridDim.x * gridDim.y * gridDim.z;
    unsigned sum, cnt, mine, sp = 0u;
    for (;;) {
        sum = 0u; cnt = 0u; mine = 0u;
#pragma unroll
        for (unsigned j = 0; j < 16; ++j) { const unsigned c = xb_ld(&bar[XB_XCNT(j)]); sum += c; cnt += (c > 0u) ? 1u : 0u; mine = (j == x) ? c : mine; }
        if (sum == G) break;
        __builtin_amdgcn_s_sleep(1);
        if ((++sp & 255u) == 0u) { if (xb_ld(&bar[XB_TMO])) break; if (sp > XB_SPIN_CAP) { atomicAdd(&bar[XB_TMO], 1u); break; } }
    }
    nloc = mine > 0u ? mine : 1u; nx = cnt > 0u ? cnt : 1u;
}
__device__ __forceinline__ void xcd_barrier(const XcdBarrier& b) {
    asm volatile("s_waitcnt vmcnt(0)" ::: "memory");
    __syncthreads();
    if (threadIdx.x == 0) {
        unsigned* bar = b.bar;
        __builtin_amdgcn_s_waitcnt(0);
        unsigned nloc = b.st[0], nx = b.st[1];
        if (nloc == 0u) { xcd_barrier_complete(bar, b.x, nloc, nx); b.st[0] = nloc; b.st[1] = nx; }
        const unsigned old = xb_add(&bar[XB_XSUB(b.x)], 1u);
        const unsigned gen = old / nloc;
        if (old + 1u == (gen + 1u) * nloc) {
            __builtin_amdgcn_fence(__ATOMIC_RELEASE, "agent");
            asm volatile("s_waitcnt vmcnt(0)" ::: "memory");
            const unsigned og = xb_add(&bar[XB_TOP], 1u);
            const unsigned tg = og / nx;
            if (og + 1u == (tg + 1u) * nx) xb_add(&bar[XB_TOPGEN], 1u);
            else XB_SPIN(xb_ld(&bar[XB_TOPGEN]) == tg, bar);
            __builtin_amdgcn_fence(__ATOMIC_ACQUIRE, "agent");
            xb_add(&bar[XB_XGEN(b.x)], 1u);
            asm volatile("s_waitcnt vmcnt(0)" ::: "memory");
        } else {
            XB_SPIN(xb_ld(&bar[XB_XGEN(b.x)]) == gen, bar);
            __builtin_amdgcn_fence(__ATOMIC_ACQUIRE, "agent");
            asm volatile("s_waitcnt vmcnt(0)" ::: "memory");
        }
    }
    __syncthreads();
}

__device__ __forceinline__ float wave_sum(float v) {
#pragma unroll
    for (int o = 1; o < 64; o <<= 1) v += __shfl_xor(v, o);
    return v;
}
__device__ __forceinline__ unsigned f2bf(float f) { unsigned u = __builtin_bit_cast(unsigned, f); return (u + 0x7fffu + ((u >> 16) & 1u)) >> 16; }
__device__ __forceinline__ unsigned pk2(float lo, float hi) { return f2bf(lo) | (f2bf(hi) << 16); }
__device__ __forceinline__ void transpose_item(const GAS float* W, int K, int N, int ldn, const GAS float* gk, GAS bf16_t* WT, int row_off, LAS float* scr, int item, int nblk, int lane) {
    const int kb = item / nblk, nb = item - kb * nblk, k0 = 64 * kb, n0 = 32 * nb;
    const int n = n0 + (lane & 31);
    float wv[32];
#pragma unroll
    for (int i = 0; i < 32; ++i) { const int kk = 2 * i + (lane >> 5); wv[i] = 0.f; if (n < N) wv[i] = __builtin_nontemporal_load(W + (size_t)(k0 + kk) * ldn + n); }
#pragma unroll
    for (int i = 0; i < 32; ++i) { const int kk = 2 * i + (lane >> 5); float v = wv[i]; if (gk) v *= gk[k0 + kk]; scr[kk * 33 + (lane & 31)] = v; }
    LDS_WAIT(); asm volatile("" ::: "memory");
    const int c = lane & 7;
#pragma unroll
    for (int j = 0; j < 4; ++j) { const int nn = (lane >> 3) + 8 * j; const LAS float* s = scr + (8 * c) * 33 + nn;
        u32x4 o; o.x = pk2(s[0 * 33], s[1 * 33]); o.y = pk2(s[2 * 33], s[3 * 33]); o.z = pk2(s[4 * 33], s[5 * 33]); o.w = pk2(s[6 * 33], s[7 * 33]);
        *(GAS u32x4*)(WT + (size_t)(row_off + n0 + nn) * K + k0 + 8 * c) = o; }
    LDS_WAIT(); asm volatile("" ::: "memory");
}
__device__ __forceinline__ void rms_row(const GAS float* xrow, GAS bf16_t* orow, int lane) {
    asm volatile("" : "+v"(lane));
    const GAS f32x4* xr = (const GAS f32x4*)xrow + lane;
    f32x4 v[8]; float s = 0.f;
#pragma unroll
    for (int j = 0; j < 8; ++j) { v[j] = xr[64 * j]; s += (v[j][0] * v[j][0] + v[j][1] * v[j][1]) + (v[j][2] * v[j][2] + v[j][3] * v[j][3]); }
    const float r = rsqrtf(wave_sum(s) * (1.f / DM) + EPS);
    GAS u32x2* o8 = (GAS u32x2*)orow + lane;
#pragma unroll
    for (int j = 0; j < 8; ++j) { u32x2 w; w.x = pk2(v[j][0] * r, v[j][1] * r); w.y = pk2(v[j][2] * r, v[j][3] * r); o8[64 * j] = w; }
}

struct Args { const float* in[18]; float* out; unsigned char* ws; };
enum { I_X = 0, I_ANG, I_AWIN, I_ABF, I_AQG, I_AKG, I_AWOUT, I_MNG, I_W1, I_W2, I_KVNG, I_KVW, I_KVKG, I_BNG, I_BWQ, I_BQG, I_BREL, I_BWOUT };

__global__ void __launch_bounds__(512, 2) fwd_megakernel(Args a) {
    extern __shared__ __attribute__((aligned(16))) unsigned char lds[];
    cg::grid_group grid = cg::this_grid();
    LAS unsigned char* L = (LAS unsigned char*)lds;
    const int wave = __builtin_amdgcn_readfirstlane(threadIdx.x >> 6);
    const int G = gridDim.x, bx = blockIdx.x;
    const int vcu = (G % 8 == 0) ? (bx % 8) * (G / 8) + bx / 8 : bx;
    GAS unsigned char* ws = (GAS unsigned char*)a.ws;
    GAS float* LF = (GAS float*)(ws + WS_LF); GAS float* GT = (GAS float*)(ws + WS_GT); GAS int* JT = (GAS int*)(ws + WS_GT + 8192);
    GAS bf16_t* WIN = (GAS bf16_t*)(ws + WS_WIN); GAS bf16_t* WOA = (GAS bf16_t*)(ws + WS_WOA); GAS bf16_t* W1T = (GAS bf16_t*)(ws + WS_W1); GAS bf16_t* W2T = (GAS bf16_t*)(ws + WS_W2);
    GAS bf16_t* WKVQ = (GAS bf16_t*)(ws + WS_WKVQ); GAS bf16_t* WOB = (GAS bf16_t*)(ws + WS_WOB);
    GAS bf16_t* U2 = (GAS bf16_t*)(ws + WS_U2); GAS float* SSQ = (GAS float*)(ws + WS_SSQ);
    GAS bf16_t* U = (GAS bf16_t*)(ws + WS_U); GAS bf16_t* QKV = (GAS bf16_t*)(ws + WS_QKV); GAS bf16_t* HID = QKV;
    GAS float* out = (GAS float*)a.out;
#define IN(i) ((const GAS float*)a.in[i])
    const int gw = vcu * 8 + wave, NGW = G * 8;
    if (threadIdx.x < 4) ((LAS unsigned*)(L + BARW_OFF))[threadIdx.x] = 0u;
    __syncthreads();
    const XcdBarrier xbar = xcd_barrier_post((unsigned*)a.ws, (volatile LAS unsigned*)(L + BARW_OFF));
#define GRID_BAR() xcd_barrier(xbar)

    for (int rep_ = 0; rep_ < (PROBE_REPEAT == 1 ? 2 : 1); ++rep_) {
        int tid = threadIdx.x; asm volatile("" : "+v"(tid)); const int lane = tid & 63;
        LAS float* scr = (LAS float*)(L + wave * 16384);
        constexpr int I0 = 32 * 200, I1 = 32 * 64, I2 = 32 * 256, I3 = 128 * 64, I4 = 32 * 128, I5 = 32 * 64, I6 = 32 * 64;
        constexpr int NITEMS = I0 + I1 + 2 * I2 + 2 * I3 + I4 + I5 + I6;
        for (int it = gw; it < NITEMS; it += NGW) {
            int r = it;
            if (r < I0) { transpose_item(IN(I_AWIN), DM, 3 * DM + NH, 3 * DM + NH, IN(I_ANG), WIN, 0, scr, r, 200, lane); continue; } r -= I0;
            if (r < I1) { transpose_item(IN(I_AWOUT), DM, DM, DM, nullptr, WOA, 0, scr, r, 64, lane); continue; } r -= I1;
            if (r < I2) { transpose_item(IN(I_W1), DM, FF, FF, IN(I_MNG), W1T, 0, scr, r, 256, lane); continue; } r -= I2;
            if (r < I2) { transpose_item(IN(I_W1) + (size_t)DM * FF, DM, FF, FF, IN(I_MNG) + DM, W1T + (size_t)FF * DM, 0, scr, r, 256, lane); continue; } r -= I2;
            if (r < I3) { transpose_item(IN(I_W2), FF, DM, DM, nullptr, W2T, 0, scr, r, 64, lane); continue; } r -= I3;
            if (r < I3) { transpose_item(IN(I_W2) + (size_t)FF * DM, FF, DM, DM, nullptr, W2T + (size_t)DM * FF, 0, scr, r, 64, lane); continue; } r -= I3;
            if (r < I4) { transpose_item(IN(I_KVW), DM, 2 * DM, 2 * DM, IN(I_KVNG), WKVQ, 0, scr, r, 128, lane); continue; } r -= I4;
            if (r < I5) { transpose_item(IN(I_BWQ), DM, DM, DM, IN(I_BNG), WKVQ, 2 * DM, scr, r, 64, lane); continue; } r -= I5;
            transpose_item(IN(I_BWOUT), DM, DM, DM, nullptr, WOB, 0, scr, r, 64, lane);
        }
        for (int m = gw; m < M; m += NGW) rms_row(IN(I_X) + (size_t)m * DM, U + (size_t)m * DM, lane);
        if (bx == 0 && tid < HD) { GT[tid] = IN(I_AQG)[tid]; GT[HD + tid] = IN(I_AKG)[tid]; GT[2 * HD + tid] = 1.f;
            GT[3 * HD + tid] = IN(I_KVKG)[tid]; GT[4 * HD + tid] = 1.f; GT[5 * HD + tid] = IN(I_BQG)[tid]; }
    }
    grid.sync();

    {
        pg8::Gemm g{U, WIN, M, NIN_A, DM}; pg8::StaticOrder S; S.init(M, NIN_A, G, bx);
        pg8::EpiQKV E{QKV, GT, 3, LF, IN(I_ABF), nullptr, (LAS float*)(L + XCH_OFF)};
#ifndef NO_EPIQKV_1
        pg8::gemm_phase<pg8::EpiQKV>(L, g, S, E);
#endif
    }
    GRID_BAR();

    if (bx < BATCH * NH) {
        int tid = threadIdx.x; asm volatile("" : "+v"(tid)); const int lane = tid & 63;
        GAS float* p = LF + (size_t)bx * SEQ + tid * 8;
        f32x4 v0 = *(const GAS f32x4*)p, v1 = *(const GAS f32x4*)(p + 4);
        v0[1] += v0[0]; v0[2] += v0[1]; v0[3] += v0[2]; v1[0] += v0[3]; v1[1] += v1[0]; v1[2] += v1[1]; v1[3] += v1[2];
        const float tot = v1[3]; float x = tot;
#pragma unroll
        for (int o = 1; o < 64; o <<= 1) { const float t = __shfl_up(x, o); if (lane >= o) x += t; }
        LAS float* wt = (LAS float*)L;
        LAS float* cs = (LAS float*)(L + 256);
        if (lane == 63) wt[wave] = x;
        float gq = 0.f, gk = 0.f;
        if (tid < 64) { gq = fmaxf(fabsf(GT[tid]), fabsf(GT[tid + 64])); gk = fmaxf(fabsf(GT[HD + tid]), fabsf(GT[HD + tid + 64]));
#pragma unroll
            for (int o = 1; o < 64; o <<= 1) { gq = fmaxf(gq, __shfl_xor(gq, o)); gk = fmaxf(gk, __shfl_xor(gk, o)); }
            if (tid == 0) wt[8] = 2.f * 1.02f * RSC * gq * gk + 30.f; }
        __syncthreads();
        float off = x - tot;
        for (int w = 0; w < wave; ++w) off += wt[w];
        v0 = v0 + off; v1 = v1 + off;
        *(GAS f32x4*)p = v0; *(GAS f32x4*)(p + 4) = v1;
        *(LAS f32x4*)(cs + tid * 8) = v0; *(LAS f32x4*)(cs + tid * 8 + 4) = v1;
        __syncthreads();
        if (tid < 16) { const int P0 = tid * 256; const float cq = cs[P0], T = wt[8]; int t = 0;
            while (t < (P0 >> 6) && cq - cs[64 * t + 63] < -T) ++t;
            JT[bx * 16 + tid] = t; }
    }
    GRID_BAR();

#ifndef NO_ATT0
    att::attn_phase<0>((char*)lds, vcu, G, QKV, QKV + SEG, QKV + 2 * SEG, U, LF, JT);
#endif
#if PROBE_REPEAT == 3
    __syncthreads(); att::attn_phase<0>((char*)lds, vcu, G, QKV, QKV + SEG, QKV + 2 * SEG, U, LF, JT);
#endif
    GRID_BAR();

    {
        pg8::Gemm g{U, WOA, M, DM, DM}; pg8::StaticOrder S; S.init(M, DM, G, bx);
        pg8::EpiResid E{IN(I_X), nullptr, nullptr, U2, SSQ, (LAS float*)(L + XCH_OFF)};
#ifndef NO_EPIRESID_1
        pg8::gemm_phase<pg8::EpiResid>(L, g, S, E);
#endif
    }
    GRID_BAR();

#define MLP_BLOCK(layer, SSQ_IN, OUTF, HB_OUT, SSQ_OUT) do { \
        { pg8::Gemm g{U2, W1T + (size_t)(layer) * FF * DM, M, FF, DM}; pg8::StaticOrder S; S.init(M, FF, G, bx); \
          pg8::EpiRelu2 E{HID, SSQ_IN}; \
          pg8::gemm_phase<pg8::EpiRelu2>(L, g, S, E); \
          if (PROBE_REPEAT == 6 && (layer) == 0) { __syncthreads(); pg8::gemm_phase<pg8::EpiRelu2>(L, g, S, E); } } \
        GRID_BAR(); \
        { pg8::Gemm g{HID, W2T + (size_t)(layer) * DM * FF, M, DM, FF}; pg8::StaticOrder S; S.init(M, DM, G, bx); \
          pg8::EpiResid E{nullptr, U2, OUTF, HB_OUT, SSQ_OUT, (LAS float*)(L + XCH_OFF)}; \
          pg8::gemm_phase<pg8::EpiResid>(L, g, S, E); } } while (0)
    MLP_BLOCK(0, SSQ, (GAS float*)nullptr, U2, SSQ + (size_t)8 * M);
    GRID_BAR();
    {
        pg8::Gemm g{U2, WKVQ, M, NIN_B, DM}; pg8::StaticOrder S; S.init(M, NIN_B, G, bx);
        pg8::EpiQKV E{QKV, GT + 3 * HD, 5, nullptr, nullptr, SSQ + (size_t)8 * M, (LAS float*)(L + XCH_OFF)};
        pg8::gemm_phase<pg8::EpiQKV>(L, g, S, E);
    }
    GRID_BAR();
    att::attn_phase<1>((char*)lds, vcu, G, QKV + 2 * SEG, QKV, QKV + SEG, U, IN(I_BREL), JT);
#if PROBE_REPEAT == 10
    __syncthreads(); att::attn_phase<1>((char*)lds, vcu, G, QKV + 2 * SEG, QKV, QKV + SEG, U, IN(I_BREL), JT);
#endif
    GRID_BAR();
    {
        pg8::Gemm g{U, WOB, M, DM, DM}; pg8::StaticOrder S; S.init(M, DM, G, bx);
        pg8::EpiResid E{nullptr, U2, nullptr, U2, SSQ + (size_t)16 * M, (LAS float*)(L + XCH_OFF)};
        pg8::gemm_phase<pg8::EpiResid>(L, g, S, E);
    }
    GRID_BAR();
    MLP_BLOCK(1, SSQ + (size_t)16 * M, out, (GAS bf16_t*)nullptr, (GAS float*)nullptr);
#undef MLP_BLOCK
}

extern "C" void kernel_launch(void* const* d_in, const int* in_sizes, int n_in, void* d_out, int out_size, void* d_ws, size_t ws_size, hipStream_t stream) {
    static int grid = 0;
    if (grid == 0) {
        if (n_in != 18 || in_sizes[0] != M * DM || out_size != M * DM || ws_size < WS_END) {
            fprintf(stderr, "kernel_launch: shape mismatch (n_in %d in0 %d out %d ws %zu)\n", n_in, n_in > 0 ? in_sizes[0] : -1, out_size, ws_size); grid = -1; return; }
        int dev = 0, cus = 0, per_cu = 0;
        (void)hipGetDevice(&dev);
        if (hipDeviceGetAttribute(&cus, hipDeviceAttributeMultiprocessorCount, dev) != hipSuccess || cus <= 0) cus = 256;
        if (hipFuncSetAttribute((const void*)fwd_megakernel, hipFuncAttributeMaxDynamicSharedMemorySize, LDS_BYTES) != hipSuccess) { fprintf(stderr, "kernel_launch: hipFuncSetAttribute failed\n"); grid = -1; return; }
        if (hipOccupancyMaxActiveBlocksPerMultiprocessor(&per_cu, (const void*)fwd_megakernel, 512, LDS_BYTES) != hipSuccess || per_cu < 1) { fprintf(stderr, "kernel_launch: occupancy query says %d\n", per_cu); per_cu = 1; }
        (void)hipGetLastError();
        grid = cus * per_cu;
    }
    if (grid < 0) return;
    if (hipMemsetAsync(d_ws, 0, 16384, stream) != hipSuccess) { fprintf(stderr, "kernel_launch: memset failed\n"); return; }
    Args a{};
    for (int i = 0; i < 18; ++i) a.in[i] = (const float*)d_in[i];
    a.out = (float*)d_out; a.ws = (unsigned char*)d_ws;
    void* args[] = {&a};
    hipError_t e = hipLaunchCooperativeKernel((const void*)fwd_megakernel, dim3(grid), dim3(512), args, LDS_BYTES, stream);
    if (e != hipSuccess) fprintf(stderr, "kernel_launch: cooperative launch failed: %s (grid %d)\n", hipGetErrorString(e), grid);
}
```

```cpp
#include <hip/hip_runtime.h>
#include <hip/hip_cooperative_groups.h>
#include <cstdio>
#include <cstdint>
namespace cg = cooperative_groups;

#ifndef PROBE_REPEAT
#define PROBE_REPEAT 0
#endif
#define LAS __attribute__((address_space(3)))
#define GAS __attribute__((address_space(1)))
typedef unsigned short bf16_t;
typedef short bf16x8 __attribute__((ext_vector_type(8)));
typedef short s16x4 __attribute__((ext_vector_type(4)));
typedef float f32x4 __attribute__((ext_vector_type(4)));
typedef float f32x16 __attribute__((ext_vector_type(16)));
typedef unsigned u32x4 __attribute__((ext_vector_type(4)));
typedef unsigned u32x2 __attribute__((ext_vector_type(2)));

constexpr int BATCH = 8, SEQ = 4096, DM = 2048, NH = 16, HD = 128, FF = 8192, NREL = 320;
constexpr int M = BATCH * SEQ;
constexpr int NIN_A = 3 * DM + 256;
constexpr int NIN_B = 3 * DM;
constexpr float EPS = 1e-6f;
constexpr float SCALE = 0.08838834764831845f;
constexpr float RSC = 11.313708498984761f;

constexpr size_t MiB = 1u << 20;
constexpr size_t WS_GT = 512 * 1024;
constexpr size_t WS_LF = 1 * MiB;
constexpr size_t WS_WIN = 4 * MiB;
constexpr size_t WS_WOA = 29 * MiB;
constexpr size_t WS_W1 = 37 * MiB;
constexpr size_t WS_W2 = 101 * MiB;
constexpr size_t WS_WKVQ = 165 * MiB;
constexpr size_t WS_WOB = 189 * MiB;
constexpr size_t WS_U = 200 * MiB;
constexpr size_t WS_QKV = 328 * MiB;
constexpr size_t SEG = (size_t)M * DM;
constexpr size_t WS_U2 = 840 * MiB;
constexpr size_t WS_SSQ = 968 * MiB;
constexpr size_t WS_END = 971 * MiB;

constexpr int RING_BYTES = 131072;
constexpr int XCH_OFF = RING_BYTES;
constexpr int BARW_OFF = XCH_OFF + 8192;
constexpr int LDS_BYTES = 147456;

__device__ __forceinline__ unsigned cvt_pk_bf16(float lo, float hi) { unsigned r; asm volatile("v_cvt_pk_bf16_f32 %0, %1, %2" : "=v"(r) : "v"(lo), "v"(hi)); return r; }
#define LDS_WAIT() asm volatile("s_waitcnt lgkmcnt(0)" ::: "memory")

namespace pg8 {
constexpr int BM = 256, BK = 64, HALF = 128, HTB = HALF * BK * 2, NXCD = 8, WGM = 8;
__host__ __device__ __forceinline__ int lds_byte(int r, int c) { const int st = (r >> 4) * 2 + (c >> 5), rr = r & 15, cc = c & 31, ob = rr * 64 + cc * 2; return st * 1024 + (ob ^ (((ob >> 9) & 1) << 5)); }
__host__ __device__ __forceinline__ void stage_rc(int b, int& R, int& C) { const int st = b / 1024, sb = b % 1024, swz = sb ^ (((sb >> 9) & 1) << 5); R = (st >> 1) * 16 + swz / 64; C = (st & 1) * 32 + (swz % 64) / 2; }
__host__ __device__ __forceinline__ int perm32(int rho) { const int n = rho >> 4, i = rho & 15; return 8 * (i >> 2) + 4 * n + (i & 3); }

struct Unit { int pm, pn; };
struct Gemm { const GAS bf16_t* A; const GAS bf16_t* Bt; int M, N, K; };

struct StaticOrder {
    int nM, nN, nwg, G, c;
    __device__ void init(int M_, int N_, int G_, int c_) { nM = M_ / BM; nN = N_ / BM; nwg = nM * nN; G = G_; c = c_; }
    __device__ bool next(int i, Unit& u) const {
        const long L = (long)i * G + c; if (L >= nwg) return false;
        int wgid = (int)L; { const int q = nwg / NXCD, r = nwg % NXCD, xcd = wgid % NXCD, off = wgid / NXCD; wgid = (xcd < r ? xcd * (q + 1) : r * (q + 1) + (xcd - r) * q) + off; }
        const int nig = WGM * nN, gid = wgid / nig, fm = gid * WGM, gsz = (nM - fm) < WGM ? (nM - fm) : WGM;
        u.pm = fm + ((wgid % nig) % gsz); u.pn = (wgid % nig) / gsz; return true;
    }
};


struct EpiQKV {
    static constexpr bool PERM = true;
    GAS bf16_t* O;
    const GAS float* gt; int normmask;
    GAS float* logf; const GAS float* bfg;
    const GAS float* ssq;
    LAS float* xch;
    __device__ __forceinline__ void operator()(const f32x4 (&acc)[2][2][4][2], const Unit& u, int wr, int wc, int fr, int fq) const {
        const int t = u.pn >> 3;
        const int row0 = u.pm * BM + wr * 64 + fr;
        if (t == 3) {
            if (wc == 0 && fq < 2) {
#pragma unroll
                for (int ai = 0; ai < 2; ++ai)
#pragma unroll
                    for (int m = 0; m < 4; ++m) { const int row = row0 + ai * HALF + m * 16; const int b = row >> 12, s = row & 4095;
#pragma unroll
                        for (int n = 0; n < 2; ++n)
#pragma unroll
                            for (int j = 0; j < 4; ++j) { const int c = 8 * fq + 4 * n + j; const float z = acc[ai][0][m][n][j] + bfg[c];
                                const float lf = fminf(z, 0.f) - __logf(1.f + __expf(-fabsf(z)));
                                logf[((size_t)(b * NH + c)) * SEQ + s] = lf; } }
            }
            return;
        }
        const GAS float* gp = gt + t * HD; const bool g = (normmask >> t) & 1;
        GAS bf16_t* base = O + (size_t)t * SEG;
        const int colt = (u.pn & 7) * BM + wc * 32 + 8 * fq;
        f32x4 gv0 = (f32x4){1.f, 1.f, 1.f, 1.f}, gv1 = gv0;
        if (g) {
#pragma unroll
            for (int ai = 0; ai < 2; ++ai)
#pragma unroll
                for (int m = 0; m < 4; ++m)
#pragma unroll
                    for (int bj = 0; bj < 2; ++bj) { const f32x4 a = acc[ai][bj][m][0], b = acc[ai][bj][m][1];
                        float s = (a[0] * a[0] + a[1] * a[1]) + (a[2] * a[2] + a[3] * a[3]) + (b[0] * b[0] + b[1] * b[1]) + (b[2] * b[2] + b[3] * b[3]);
                        s += __shfl_xor(s, 16); s += __shfl_xor(s, 32);
                        if (fq == 0) xch[((ai * HALF + wr * 64 + m * 16 + fr) * 2 + bj) * 4 + wc] = s; }
            LDS_WAIT(); __builtin_amdgcn_s_barrier(); asm volatile("" ::: "memory");
            int go = wc * 32 + 8 * fq; asm volatile("" : "+v"(go));
            gv0 = *(const GAS f32x4*)(gp + go); gv1 = *(const GAS f32x4*)(gp + go + 4);
        }
#pragma unroll
        for (int ai = 0; ai < 2; ++ai)
#pragma unroll
            for (int m = 0; m < 4; ++m) { GAS bf16_t* rowp = base + (size_t)(row0 + ai * HALF + m * 16) * DM + colt;
                float r0 = 1.f, r1 = 1.f, rw = 1.f, rw2 = 1.f;
                if (ssq) { const GAS f32x4* pp = (const GAS f32x4*)(ssq + (size_t)(row0 + ai * HALF + m * 16) * 8); const f32x4 p = pp[0], q = pp[1];
                    rw2 = 1.f / ((((p[0] + p[1]) + (p[2] + p[3])) + ((q[0] + q[1]) + (q[2] + q[3]))) * (1.f / DM) + EPS); rw = sqrtf(rw2); }
                if (g) { const LAS f32x4* pp = (const LAS f32x4*)(xch + ((ai * HALF + wr * 64 + m * 16 + fr) * 2) * 4); const f32x4 p = pp[0], q = pp[1];
                    r0 = rsqrtf(((p[0] + p[1]) + (p[2] + p[3])) * rw2 * (1.f / 128.f) + EPS); r1 = rsqrtf(((q[0] + q[1]) + (q[2] + q[3])) * rw2 * (1.f / 128.f) + EPS); }
                r0 *= rw; r1 *= rw;
#pragma unroll
                for (int bj = 0; bj < 2; ++bj) { const float rr = bj ? r1 : r0; const f32x4 v0 = acc[ai][bj][m][0] * rr * gv0, v1 = acc[ai][bj][m][1] * rr * gv1;
                    u32x4 w; w.x = cvt_pk_bf16(v0[0], v0[1]); w.y = cvt_pk_bf16(v0[2], v0[3]); w.z = cvt_pk_bf16(v1[0], v1[1]); w.w = cvt_pk_bf16(v1[2], v1[3]);
                    *(GAS u32x4*)(rowp + bj * HALF) = w; }
                asm volatile("" ::: "memory"); }
    }
};
struct EpiResid {
    static constexpr bool PERM = false;
    const GAS float* xf; const GAS bf16_t* hin; GAS float* outf; GAS bf16_t* hb; GAS float* ssq;
    LAS float* xch;
    __device__ __forceinline__ void operator()(const f32x4 (&acc)[2][2][4][2], const Unit& u, int wr, int wc, int fr, int fq) const {
        const int row0 = u.pm * BM + wr * 64 + fr, col0 = u.pn * BM + wc * 32 + 4 * fq;
#pragma unroll
        for (int ai = 0; ai < 2; ++ai)
#pragma unroll
            for (int m = 0; m < 4; ++m) { const int row = row0 + ai * HALF + m * 16; const size_t off = (size_t)row * DM + col0;
                f32x4 bs[2][2];
                if (xf) {
#pragma unroll
                    for (int bj = 0; bj < 2; ++bj)
#pragma unroll
                        for (int n = 0; n < 2; ++n) bs[bj][n] = *(const GAS f32x4*)(xf + off + bj * HALF + n * 16);
                } else {
                    u32x2 hw[2][2];
#pragma unroll
                    for (int bj = 0; bj < 2; ++bj)
#pragma unroll
                        for (int n = 0; n < 2; ++n) hw[bj][n] = *(const GAS u32x2*)(hin + off + bj * HALF + n * 16);
#pragma unroll
                    for (int bj = 0; bj < 2; ++bj)
#pragma unroll
                        for (int n = 0; n < 2; ++n) { const u32x2 w = hw[bj][n];
                            bs[bj][n] = (f32x4){__uint_as_float(w.x << 16), __uint_as_float(w.x & 0xffff0000u), __uint_as_float(w.y << 16), __uint_as_float(w.y & 0xffff0000u)}; }
                }
                float sq = 0.f;
#pragma unroll
                for (int bj = 0; bj < 2; ++bj)
#pragma unroll
                    for (int n = 0; n < 2; ++n) { const f32x4 v = acc[ai][bj][m][n] + bs[bj][n];
                        if (outf) *(GAS f32x4*)(outf + off + bj * HALF + n * 16) = v;
                        if (hb) { u32x2 w; w.x = cvt_pk_bf16(v[0], v[1]); w.y = cvt_pk_bf16(v[2], v[3]); *(GAS u32x2*)(hb + off + bj * HALF + n * 16) = w;
                            sq += (v[0] * v[0] + v[1] * v[1]) + (v[2] * v[2] + v[3] * v[3]); } }
                if (hb) { sq += __shfl_xor(sq, 16); sq += __shfl_xor(sq, 32); if (fq == 0) xch[(ai * HALF + wr * 64 + m * 16 + fr) * 4 + wc] = sq; }
                asm volatile("" ::: "memory"); }
        if (hb) { LDS_WAIT(); __builtin_amdgcn_s_barrier(); asm volatile("" ::: "memory");
            const int t = wr * 256 + wc * 64 + fq * 16 + fr;
            if (t < 256) { const f32x4 p = *(const LAS f32x4*)(xch + t * 4); ssq[(size_t)(u.pm * BM + t) * 8 + u.pn] = (p[0] + p[1]) + (p[2] + p[3]); } }
    }
};
struct EpiRelu2 {
    static constexpr bool PERM = true;
    GAS bf16_t* O; const GAS float* ssq;
    __device__ __forceinline__ void operator()(const f32x4 (&acc)[2][2][4][2], const Unit& u, int wr, int wc, int fr, int fq) const {
        const int row0 = u.pm * BM + wr * 64 + fr, col0 = u.pn * BM + wc * 32 + 8 * fq;
#pragma unroll
        for (int ai = 0; ai < 2; ++ai)
#pragma unroll
            for (int m = 0; m < 4; ++m) { GAS bf16_t* rowp = O + (size_t)(row0 + ai * HALF + m * 16) * FF + col0;
                float r2; { const GAS f32x4* pp = (const GAS f32x4*)(ssq + (size_t)(row0 + ai * HALF + m * 16) * 8); const f32x4 p = pp[0], q = pp[1];
                    r2 = 1.f / ((((p[0] + p[1]) + (p[2] + p[3])) + ((q[0] + q[1]) + (q[2] + q[3]))) * (1.f / DM) + EPS); }
#pragma unroll
                for (int bj = 0; bj < 2; ++bj) { f32x4 v0 = acc[ai][bj][m][0], v1 = acc[ai][bj][m][1];
#pragma unroll
                    for (int j = 0; j < 4; ++j) { v0[j] = fmaxf(v0[j], 0.f); v1[j] = fmaxf(v1[j], 0.f); }
                    v0 = v0 * v0 * r2; v1 = v1 * v1 * r2;
                    u32x4 w; w.x = cvt_pk_bf16(v0[0], v0[1]); w.y = cvt_pk_bf16(v0[2], v0[3]); w.z = cvt_pk_bf16(v1[0], v1[1]); w.w = cvt_pk_bf16(v1[2], v1[3]);
                    *(GAS u32x4*)(rowp + bj * HALF) = w; } }
    }
};

template <class Epi>
__device__ __forceinline__ void gemm_phase(LAS unsigned char* lds, Gemm g, const StaticOrder& S, const Epi& E) {
    int tid = threadIdx.x; asm volatile("" : "+v"(tid));
    asm volatile("" : "+s"(g.A), "+s"(g.Bt));
    const int wid = __builtin_amdgcn_readfirstlane(tid >> 6), lane = tid & 63, wr = wid >> 2, wc = wid & 3, fr = lane & 15, fq = lane >> 4;
    const int K = g.K, nt = K / BK;
    unsigned voffA[2], voffB[2];
#pragma unroll
    for (int i = 0; i < 2; ++i) { int R, C; stage_rc(tid * 16 + i * 8192, R, C); const int Rb = Epi::PERM ? ((R & ~31) + perm32(R & 31)) : R;
        voffA[i] = (unsigned)(R * K + C) * 2u; voffB[i] = (unsigned)(Rb * K + C) * 2u; }
    const size_t kstep = (size_t)(BK * 2);
    const size_t hstep = (size_t)HALF * K * 2;
    const size_t tstep = 2 * hstep;
    const unsigned ldsw = (unsigned)wid * 1024u;
    const int aoff = lds_byte(wr * 64 + fr, fq * 8), boff = lds_byte(wc * 32 + fr, fq * 8);
#define PG8_SA(b, h) (((b) * 2 + (h)) * HTB)
#define PG8_SB(b, h) ((4 + (b) * 2 + (h)) * HTB)
#define PG8_STAGE(bufoff, gbase, voff) do { _Pragma("unroll") for (int _i = 0; _i < 2; ++_i) \
        __builtin_amdgcn_global_load_lds((const GAS unsigned*)((const GAS char*)(gbase) + (voff)[_i]), (LAS unsigned*)(lds + (bufoff) + ldsw + _i * 8192), 16, 0, 0); } while (0)
#define PG8_LDA(dst, b, h) do { _Pragma("unroll") for (int m = 0; m < 4; ++m) _Pragma("unroll") for (int k = 0; k < 2; ++k) dst[m][k] = *(const LAS bf16x8*)(lds + PG8_SA(b, h) + aoff + m * 2048 + k * 1024); } while (0)
#define PG8_LDB(dst, b, h) do { _Pragma("unroll") for (int n = 0; n < 2; ++n) _Pragma("unroll") for (int k = 0; k < 2; ++k) dst[n][k] = *(const LAS bf16x8*)(lds + PG8_SB(b, h) + boff + n * 2048 + k * 1024); } while (0)
#define PG8_MMA(ai, bj, At, Bt) do { __builtin_amdgcn_s_setprio(1); _Pragma("unroll") for (int m = 0; m < 4; ++m) _Pragma("unroll") for (int n = 0; n < 2; ++n) _Pragma("unroll") for (int k = 0; k < 2; ++k) \
        acc[ai][bj][m][n] = __builtin_amdgcn_mfma_f32_16x16x32_bf16(Bt[n][k], At[m][k], acc[ai][bj][m][n], 0, 0, 0); __builtin_amdgcn_s_setprio(0); } while (0)
#define PG8_WAIT_V(n) asm volatile("s_waitcnt vmcnt(" #n ")" ::: "memory")
#define PG8_WAIT_L(n) asm volatile("s_waitcnt lgkmcnt(" #n ")" ::: "memory")
#define PG8_BAR __builtin_amdgcn_s_barrier()
#define PG8_SCHED __builtin_amdgcn_sched_barrier(0)
    Unit cur, nxt; int ui = 0;
    if (!S.next(0, cur)) return;
    f32x4 acc[2][2][4][2];
#pragma unroll
    for (int a = 0; a < 2; ++a)
#pragma unroll
        for (int b = 0; b < 2; ++b)
#pragma unroll
            for (int m = 0; m < 4; ++m)
#pragma unroll
                for (int n = 0; n < 2; ++n) acc[a][b][m][n] = (f32x4){0.f, 0.f, 0.f, 0.f};
    bf16x8 At[4][2], B0[2][2], B1[2][2];
    const GAS char* cA = (const GAS char*)g.A + (size_t)cur.pm * tstep; const GAS char* cB = (const GAS char*)g.Bt + (size_t)cur.pn * tstep;
    PG8_STAGE(PG8_SB(0, 0), cB, voffB); PG8_STAGE(PG8_SB(0, 1), cB + hstep, voffB); PG8_STAGE(PG8_SA(0, 0), cA, voffA); PG8_STAGE(PG8_SA(0, 1), cA + hstep, voffA);
    if (wr == 1) PG8_BAR;
    PG8_WAIT_V(2); PG8_BAR;
    PG8_STAGE(PG8_SB(1, 0), cB + kstep, voffB); PG8_STAGE(PG8_SA(1, 0), cA + kstep, voffA); PG8_STAGE(PG8_SB(1, 1), cB + hstep + kstep, voffB);
    PG8_WAIT_V(6); PG8_BAR;
    for (;;) {
        const bool has_next = S.next(ui + 1, nxt);
        const GAS char* nA = has_next ? (const GAS char*)g.A + (size_t)nxt.pm * tstep : cA; const GAS char* nB = has_next ? (const GAS char*)g.Bt + (size_t)nxt.pn * tstep : cB;
        for (int t = 0; t < nt; t += 2) {
            const bool last = (t == nt - 2);
            const GAS char* a1 = cA + (size_t)(t + 1) * kstep;
            const GAS char* a2 = last ? nA : cA + (size_t)(t + 2) * kstep; const GAS char* b2 = last ? nB : cB + (size_t)(t + 2) * kstep;
            const GAS char* a3 = a2 + kstep; const GAS char* b3 = b2 + kstep;
            PG8_LDB(B0, 0, 0); PG8_LDB(B1, 0, 1); PG8_SCHED; PG8_LDA(At, 0, 0); PG8_STAGE(PG8_SA(1, 1), a1 + hstep, voffA);
            PG8_WAIT_V(8); PG8_WAIT_L(0); PG8_BAR; PG8_MMA(0, 0, At, B0); PG8_MMA(0, 1, At, B1); PG8_BAR; PG8_SCHED;
            PG8_LDA(At, 0, 1); PG8_STAGE(PG8_SB(0, 0), b2, voffB); PG8_STAGE(PG8_SB(0, 1), b2 + hstep, voffB); PG8_STAGE(PG8_SA(0, 0), a2, voffA);
            PG8_WAIT_V(8); PG8_WAIT_L(0); PG8_BAR; PG8_MMA(1, 0, At, B0); PG8_MMA(1, 1, At, B1); PG8_BAR; PG8_SCHED;
            PG8_LDB(B0, 1, 0); PG8_LDB(B1, 1, 1); PG8_SCHED; PG8_LDA(At, 1, 0); PG8_STAGE(PG8_SA(0, 1), a2 + hstep, voffA);
            PG8_WAIT_V(8); PG8_WAIT_L(0); PG8_BAR; PG8_MMA(0, 0, At, B0); PG8_MMA(0, 1, At, B1); PG8_BAR; PG8_SCHED;
            PG8_LDA(At, 1, 1); PG8_STAGE(PG8_SB(1, 0), b3, voffB); PG8_STAGE(PG8_SB(1, 1), b3 + hstep, voffB); PG8_STAGE(PG8_SA(1, 0), a3, voffA);
            PG8_WAIT_V(8); PG8_WAIT_L(0); PG8_BAR; PG8_MMA(1, 0, At, B0); PG8_MMA(1, 1, At, B1); PG8_BAR; PG8_SCHED;
        }
        if (wr == 0) PG8_BAR;
        E(acc, cur, wr, wc, fr, fq);
        if (!has_next) break;
#pragma unroll
        for (int a = 0; a < 2; ++a)
#pragma unroll
            for (int b = 0; b < 2; ++b)
#pragma unroll
                for (int m = 0; m < 4; ++m)
#pragma unroll
                    for (int n = 0; n < 2; ++n) acc[a][b][m][n] = (f32x4){0.f, 0.f, 0.f, 0.f};
        cur = nxt; cA = nA; cB = nB; ++ui;
        if (wr == 1) PG8_BAR;
    }
    PG8_WAIT_V(0);
    PG8_BAR;
#undef PG8_SA
#undef PG8_SB
#undef PG8_STAGE
#undef PG8_LDA
#undef PG8_LDB
#undef PG8_MMA
#undef PG8_WAIT_V
#undef PG8_WAIT_L
#undef PG8_BAR
#undef PG8_SCHED
}
}

namespace att {
constexpr int D = 128, RS = 2048, NW = 8, QBLK = 32, KVBLK = 64, QB = NW * QBLK;
constexpr int SHM_V = KVBLK * D * 2, SHM_K = KVBLK * D * 2;
constexpr int OFF_WS = 2 * SHM_V + 2 * SHM_K;
constexpr int OFF_BIAS = OFF_WS + NW * 64 * 4;
constexpr int CST = 648;
constexpr float THR = 8.f;

#define KSWZ(row, colB) ((row) * 256 + ((colB) ^ (((row) & 7) << 4)))
#define SBAR() __builtin_amdgcn_sched_barrier(0)
__device__ __forceinline__ int v_st(int k, int c) { const int kk = (k & ~0xC) | ((k & 4) << 1) | ((k & 8) >> 1); return ((kk >> 3) * 4 + (c >> 5)) * 512 + ((kk & 7) * 32 + (c & 31)) * 2; }
__device__ __forceinline__ int v_rd_base(int lane) { return ((lane & 3) << 3) | (((lane >> 2) & 3) << 6) | (((lane >> 4) & 1) << 5) | (((lane >> 5) & 1) << 8); }
constexpr int v_rd_off(int d0, int ks, int half) { return d0 * 512 + ks * 4096 + half * 2048; }
__device__ __forceinline__ int crow(int r, int hi) { return (r & 3) + 8 * (r >> 2) + 4 * hi; }
__device__ __forceinline__ unsigned cvtpk(float lo, float hi) { unsigned r; asm volatile("v_cvt_pk_bf16_f32 %0, %1, %2" : "=v"(r) : "v"(lo), "v"(hi)); return r; }
__device__ __forceinline__ bf16x8 load8(const GAS bf16_t* p) { return *(const GAS bf16x8*)(p); }

__device__ __forceinline__ void mask_tile(f32x16& p0, f32x16& p1, int dq, unsigned W) {
    const float NEG = -__builtin_inff();
#pragma unroll
    for (int r = 0; r < 16; ++r) {
        const int c = (r & 3) + 8 * (r >> 2);
        if ((unsigned)(dq - c) >= W) p0[r] = NEG;
        if ((unsigned)(dq - c - 32) >= W) p1[r] = NEG;
    }
}
__device__ __forceinline__ void partialSM(f32x16& p0, f32x16& p1, float& m_reg, float& mn, float& alpha) {
    float pmax = p0[0];
#pragma unroll
    for (int r = 1; r < 16; ++r) pmax = fmaxf(pmax, p0[r]);
#pragma unroll
    for (int r = 0; r < 16; ++r) pmax = fmaxf(pmax, p1[r]);
    { auto rr = __builtin_amdgcn_permlane32_swap(__float_as_uint(pmax), __float_as_uint(pmax), false, false);
      pmax = fmaxf(__uint_as_float(rr[0]), __uint_as_float(rr[1])); }
    constexpr float C2 = 1.4426950408889634f * SCALE;
    if (__builtin_expect(__all((pmax - m_reg) * SCALE <= THR), 1)) { mn = m_reg; alpha = 1.f; }
    else { mn = fmaxf(m_reg, pmax); alpha = __builtin_amdgcn_exp2f((m_reg - mn) * C2); m_reg = mn; }
    const float mnL = -mn * C2;
#pragma unroll
    for (int r = 0; r < 16; ++r) p0[r] = fmaf(p0[r], C2, mnL);
#pragma unroll
    for (int r = 0; r < 16; ++r) p1[r] = fmaf(p1[r], C2, mnL);
#pragma unroll
    for (int r = 0; r < 16; ++r) p0[r] = __builtin_amdgcn_exp2f(p0[r]);
}
__device__ __forceinline__ void finishSM(f32x16& p0, f32x16& p1, float alpha, float& l_reg, bf16x8& pa0, bf16x8& pa1, bf16x8& pa2, bf16x8& pa3) {
#pragma unroll
    for (int r = 0; r < 16; ++r) p1[r] = __builtin_amdgcn_exp2f(p1[r]);
    float ps = 0;
#pragma unroll
    for (int r = 0; r < 16; ++r) ps += p0[r];
#pragma unroll
    for (int r = 0; r < 16; ++r) ps += p1[r];
    { auto rr = __builtin_amdgcn_permlane32_swap(__float_as_uint(ps), __float_as_uint(ps), false, false);
      ps = __uint_as_float(rr[0]) + __uint_as_float(rr[1]); }
    l_reg = l_reg * alpha + ps;
#define PK4(P, B_, OUT) do { unsigned a0 = cvtpk(P[B_+0], P[B_+1]), a1 = cvtpk(P[B_+2], P[B_+3]);                          \
        unsigned b0 = cvtpk(P[B_+4], P[B_+5]), b1 = cvtpk(P[B_+6], P[B_+7]);                                             \
        auto r0 = __builtin_amdgcn_permlane32_swap(a0, b0, false, false); auto r1 = __builtin_amdgcn_permlane32_swap(a1, b1, false, false); \
        u32x4 w = {r0[0], r1[0], r0[1], r1[1]}; OUT = *reinterpret_cast<bf16x8*>(&w); } while (0)
    PK4(p0, 0, pa0); PK4(p0, 8, pa1); PK4(p1, 0, pa2); PK4(p1, 8, pa3);
#undef PK4
}
template <int KB, bool SK>
__device__ __forceinline__ void qkt(f32x16& p0, f32x16& p1, const char* K_lds, int r32, int hi, const bf16x8* qr, bool act, const char* bp) {
    if (SK && !act) { const float NEG = -__builtin_inff();
#pragma unroll
        for (int r = 0; r < 16; ++r) { p0[r] = NEG; p1[r] = NEG; } return; }
    { const f32x4 b0 = *(const f32x4*)(bp), b1 = *(const f32x4*)(bp + 32), b2 = *(const f32x4*)(bp + 64), b3 = *(const f32x4*)(bp + 96);
      const f32x4 b4 = *(const f32x4*)(bp + 128), b5 = *(const f32x4*)(bp + 160), b6 = *(const f32x4*)(bp + 192), b7 = *(const f32x4*)(bp + 224);
      p0 = (f32x16){b0[0], b0[1], b0[2], b0[3], b1[0], b1[1], b1[2], b1[3], b2[0], b2[1], b2[2], b2[3], b3[0], b3[1], b3[2], b3[3]};
      p1 = (f32x16){b4[0], b4[1], b4[2], b4[3], b5[0], b5[1], b5[2], b5[3], b6[0], b6[1], b6[2], b6[3], b7[0], b7[1], b7[2], b7[3]}; }
    const char* kb[4];
#pragma unroll
    for (int dd = 0; dd < 4; ++dd) kb[dd] = K_lds + KB * SHM_K + KSWZ(r32, (dd * 16 + hi * 8) * 2);
#pragma unroll
    for (int d0 = 0; d0 < 8; ++d0) { const char* a = kb[d0 & 3] + (d0 >> 2) * 128;
        bf16x8 b0 = *reinterpret_cast<const bf16x8*>(a);
        bf16x8 b1 = *reinterpret_cast<const bf16x8*>(a + 32 * 256);
        p0 = __builtin_amdgcn_mfma_f32_32x32x16_bf16(b0, qr[d0], p0, 0, 0, 0);
        p1 = __builtin_amdgcn_mfma_f32_32x32x16_bf16(b1, qr[d0], p1, 0, 0, 0); }
}
template <int VB, bool SK>
__device__ __forceinline__ void pv_tile(f32x16* o, int vb0, bf16x8 pa0, bf16x8 pa1, bf16x8 pa2, bf16x8 pa3, bool act) {
    if (SK && !act) return;
#define TRRD(dst, off) asm volatile("ds_read_b64_tr_b16 %0, %1 offset:%2" : "=&v"(dst) : "v"(vb0), "i"(off) : "memory")
#define PV_D0(d0) do { s16x4 l0, l1, l2, l3, h0, h1, h2, h3; constexpr int b_ = VB * SHM_V + v_rd_off(d0, 0, 0); \
        TRRD(l0, b_); TRRD(h0, b_ + 2048); TRRD(l1, b_ + 4096); TRRD(h1, b_ + 6144); TRRD(l2, b_ + 8192); TRRD(h2, b_ + 10240); TRRD(l3, b_ + 12288); TRRD(h3, b_ + 14336); \
        asm volatile("s_waitcnt lgkmcnt(0)" ::: "memory"); SBAR();   \
        o[d0] = __builtin_amdgcn_mfma_f32_32x32x16_bf16(pa0, (bf16x8){l0[0], l0[1], l0[2], l0[3], h0[0], h0[1], h0[2], h0[3]}, o[d0], 0, 0, 0);   \
        o[d0] = __builtin_amdgcn_mfma_f32_32x32x16_bf16(pa1, (bf16x8){l1[0], l1[1], l1[2], l1[3], h1[0], h1[1], h1[2], h1[3]}, o[d0], 0, 0, 0);   \
        o[d0] = __builtin_amdgcn_mfma_f32_32x32x16_bf16(pa2, (bf16x8){l2[0], l2[1], l2[2], l2[3], h2[0], h2[1], h2[2], h2[3]}, o[d0], 0, 0, 0);   \
        o[d0] = __builtin_amdgcn_mfma_f32_32x32x16_bf16(pa3, (bf16x8){l3[0], l3[1], l3[2], l3[3], h3[0], h3[1], h3[2], h3[3]}, o[d0], 0, 0, 0); } while (0)
    PV_D0(0); PV_D0(1); PV_D0(2); PV_D0(3);
#undef PV_D0
#undef TRRD
}

struct BlockRef { const GAS bf16_t* Q; const GAS bf16_t* K; const GAS bf16_t* V; GAS bf16_t* O; const GAS float* bt; int P0; int jl; };
struct Seam { bf16x8 qr[8]; bf16x8 st_v0, st_v1, st_k0, st_k1; };

#define ROW(p, k0, rr) ((p) + (size_t)((k0) + (rr)) * RS + sc)
#define VMW() asm volatile("s_waitcnt vmcnt(0)" ::: "memory")
#define VMWN(n) asm volatile("s_waitcnt vmcnt(%0)" :: "i"(n) : "memory")
#define SLOAD_H(Kp, Vp, k0) do { S.st_v0 = load8(ROW(Vp, k0, sr)); S.st_v1 = load8(ROW(Vp, k0, 32 + sr));              \
                         S.st_k0 = load8(ROW(Kp, k0, sr)); S.st_k1 = load8(ROW(Kp, k0, 32 + sr)); } while (0)
#define SWRITE_HK(bf) do { *(bf16x8*)(K_lds + (bf) * SHM_K + kws) = S.st_k0; *(bf16x8*)(K_lds + (bf) * SHM_K + kws + 32 * 256) = S.st_k1; } while (0)
#define SWRITE_HV(bf) do { *(bf16x8*)(V_lds + (bf) * SHM_V + vst0) = S.st_v0; *(bf16x8*)(V_lds + (bf) * SHM_V + vst1) = S.st_v1; } while (0)
#define SWRITE_H(bf) do { SWRITE_HV(bf); SWRITE_HK(bf); } while (0)

template <int MODE>
__device__ __forceinline__ void attn_prime(const BlockRef& cur, char* lds, Seam& S) {
    int tid = threadIdx.x; asm volatile("" : "+v"(tid));
    const int wid = __builtin_amdgcn_readfirstlane(tid >> 6), lane = tid & 63, r32 = lane & 31, hi = lane >> 5;
    const int sr = tid >> 4, sc = (tid & 15) * 8, kws = KSWZ(sr, sc * 2); char* K_lds = lds + 2 * SHM_V;
    const int kb0 = cur.jl * KVBLK;
#pragma unroll
    for (int d0 = 0; d0 < 8; ++d0) S.qr[d0] = load8(cur.Q + (size_t)(wid * QBLK + r32) * RS + d0 * 16 + hi * 8);
    SLOAD_H(cur.K, cur.V, kb0); VMW(); SWRITE_HK(0);
    __syncthreads();
}
template <int MODE>
__device__ __forceinline__ void attn_block(const BlockRef& cur, const BlockRef& nxt, char* lds, Seam& S) {
    constexpr bool SK = (MODE == 1);
    int tid = threadIdx.x; asm volatile("" : "+v"(tid));
    const int wid = __builtin_amdgcn_readfirstlane(tid >> 6), lane = tid & 63, r32 = lane & 31, hi = lane >> 5;
    const int j_lo = cur.jl;
    const int j_hi = (cur.P0 >> 6) + 4;
    const int NT = j_hi - j_lo;
    const int kbn = nxt.jl * KVBLK;
    const int qlo = cur.P0 + wid * QBLK, qm = qlo + r32 - 4 * hi;
    const int cw = (cur.P0 >> 6) + (wid >> 1);
    char* V_lds = lds; char* K_lds = lds + 2 * SHM_V;
    float* ws = (float*)(lds + OFF_WS) + wid * 64; float* li_l = ws, * al_l = ws + 32;
    { float* tab = (float*)(lds + OFF_BIAS);
      if (MODE == 0) { const float cref = cur.bt[cur.P0]; const int nk = cur.P0 + QB;
          _Pragma("clang loop vectorize(disable) unroll(disable)") for (int i = j_lo * KVBLK + tid; i < nk; i += NW * 64) tab[i] = (cref - cur.bt[i]) * RSC; }
      else { _Pragma("clang loop vectorize(disable) unroll(disable)") for (int i = tid; i < 4 * CST; i += NW * 64) { const int a = i / CST, j = i - a * CST + a; int dist = 575 - j; dist = dist < -63 ? -63 : (dist > 256 ? 256 : dist);
                 tab[i] = cur.bt[dist + 63] * RSC; } }
      __syncthreads(); }
    int bl;
    if (MODE == 0) bl = OFF_BIAS + 16 * hi;
    else { const int tpos = cur.P0 + wid * QBLK + r32; const int a = (575 - tpos) & 3; bl = OFF_BIAS + a * (CST * 4) + 4 * (575 - tpos - a + 4 * hi); }
    asm volatile("" : "+v"(bl));
    float m_reg = -1e30f, l_reg = 0; f32x16 o[4] = {};
    const int sr = tid >> 4, sc = (tid & 15) * 8, vst0 = v_st(sr, sc), vst1 = v_st(32 + sr, sc), kws = KSWZ(sr, sc * 2);
    const int vb0 = (int)(uintptr_t)V_lds + v_rd_base(lane);
    const GAS bf16_t* Kh = cur.K; const GAS bf16_t* Vh = cur.V;
#define RESC(a) do { if (__any((a) < 1.f)) { if (hi == 0) al_l[r32] = (a); asm volatile("s_waitcnt lgkmcnt(0)" ::: "memory");              \
                     for (int d_ = 0; d_ < 4; ++d_) for (int r = 0; r < 16; ++r) o[d_][r] *= al_l[crow(r, hi)]; } } while (0)
#define KBASE(t) ((j_lo + (t)) * KVBLK)
#define BP(t) (lds + (bl + ((MODE == 0 || ACT(t)) ? KBASE(t) : cw * KVBLK) * 4))
#define ACT(t) (MODE == 0 ? true : ((j_lo + (t)) <= cw && (j_lo + (t)) >= cw - 8))
#define MASKT(P0_, P1_, t) do { if (MODE == 0) { const int kb_ = KBASE(t); if (kb_ + KVBLK - 1 > qlo) mask_tile(P0_, P1_, qm - kb_, 0x7fffffffu); } \
        else if (!ACT(t)) { const float NEG_ = -__builtin_inff(); _Pragma("unroll") for (int r_ = 0; r_ < 16; ++r_) { P0_[r_] = NEG_; P1_[r_] = NEG_; } } } while (0)
    constexpr int NQL = 8;
#define SEAM_K0() do { VMWN(NQL); SWRITE_HK(0); SBAR(); } while (0)
    f32x16 pA0, pA1, pB0, pB1; float mnA, mnB, alA, alB; bf16x8 pa0, pa1, pa2, pa3;
    SWRITE_HV(0); SBAR();
    if (NT > 1) { SLOAD_H(Kh, Vh, KBASE(1)); }
    SBAR(); qkt<0, SK>(pA0, pA1, K_lds, r32, hi, S.qr, ACT(0), BP(0));
    MASKT(pA0, pA1, 0); partialSM(pA0, pA1, m_reg, mnA, alA);
    if (NT > 1) { VMW(); SWRITE_H(1); }
    __syncthreads();
#define HALF_STEP(PX0, PX1, mnX, alX, PY0, PY1, alY, t, KB, VB, SB) do {                                                      \
        SBAR(); qkt<KB, SK>(PX0, PX1, K_lds, r32, hi, S.qr, ACT(t), BP(t));                                      \
        finishSM(PY0, PY1, alY, l_reg, pa0, pa1, pa2, pa3); SBAR();                                                           \
        if ((t) + 1 < NT) { SLOAD_H(Kh, Vh, KBASE((t) + 1)); SBAR(); }                                                        \
        pv_tile<VB, SK>(o, vb0, pa0, pa1, pa2, pa3, ACT((t) - 1)); MASKT(PX0, PX1, (t)); partialSM(PX0, PX1, m_reg, mnX, alX); \
        __syncthreads();                                                                                                      \
        if ((t) + 1 < NT) { VMW(); SWRITE_H(SB); }                                                                            \
        RESC(alX); __syncthreads(); } while (0)
    for (int t = 1; t + 1 < NT; t += 2) {
        HALF_STEP(pB0, pB1, mnB, alB, pA0, pA1, alA, t, 1, 0, 0);
        HALF_STEP(pA0, pA1, mnA, alA, pB0, pB1, alB, t + 1, 0, 1, 1);
    }
    const bool even = (NT & 1) == 0;
    if (even) { SBAR(); qkt<1, SK>(pB0, pB1, K_lds, r32, hi, S.qr, ACT(NT - 1), BP(NT - 1)); SBAR(); }
    SLOAD_H(nxt.K, nxt.V, kbn); SBAR();
#pragma unroll
    for (int d0 = 0; d0 < 8; ++d0) S.qr[d0] = load8(nxt.Q + (size_t)(wid * QBLK + r32) * RS + d0 * 16 + hi * 8);
    SBAR();
    finishSM(pA0, pA1, alA, l_reg, pa0, pa1, pa2, pa3); SBAR();
    pv_tile<0, SK>(o, vb0, pa0, pa1, pa2, pa3, ACT(even ? NT - 2 : NT - 1));
    if (even) { MASKT(pB0, pB1, NT - 1); partialSM(pB0, pB1, m_reg, mnB, alB); __syncthreads(); RESC(alB);
        finishSM(pB0, pB1, alB, l_reg, pa0, pa1, pa2, pa3); SBAR(); pv_tile<1, SK>(o, vb0, pa0, pa1, pa2, pa3, ACT(NT - 1)); }
    SBAR(); SEAM_K0();
    if (hi == 0) li_l[r32] = l_reg; asm volatile("s_waitcnt lgkmcnt(0)" ::: "memory");
    float rli[16];
#pragma unroll
    for (int r = 0; r < 16; ++r) rli[r] = __builtin_amdgcn_rcpf(li_l[crow(r, hi)]);
    GAS bf16_t* Ow = cur.O + (size_t)(wid * QBLK) * RS;
#pragma unroll
    for (int r = 0; r < 16; ++r) { const int orow = crow(r, hi);
#pragma unroll
        for (int d0 = 0; d0 < 4; ++d0) { const float v = o[d0][r] * rli[r];
            const float vn = __shfl_xor(v, 1);
            if ((r32 & 1) == 0) *(GAS unsigned*)(Ow + (size_t)orow * RS + d0 * 32 + r32) = cvtpk(v, vn); } }
    __syncthreads();
#undef RESC
#undef KBASE
#undef BP
#undef ACT
#undef MASKT
#undef SEAM_K0
#undef HALF_STEP
}
#undef ROW
#undef VMW
#undef VMWN
#undef SLOAD_H
#undef SWRITE_HK
#undef SWRITE_HV
#undef SWRITE_H

template <int MODE>
__device__ __forceinline__ BlockRef block_ref(int n, int vcu, int G, const GAS bf16_t* Q, const GAS bf16_t* K, const GAS bf16_t* V, GAS bf16_t* O, const GAS float* bt, const GAS int* jtab) {
    int bh, qb;
    if (MODE == 0) {
        if (G == 2 * BATCH * NH) { bh = vcu >> 1; const int p = n >> 1; qb = (vcu & 1) ? ((n & 1) ? 13 - 4 * p : 14 - 4 * p) : ((n & 1) ? 12 - 4 * p : 15 - 4 * p); }
        else { const int L = vcu + n * G; bh = L >> 4; qb = 15 - (L & 15); }
    } else { const int L = vcu + n * G; bh = L >> 4; qb = L & 15; }
    const int b = bh >> 4, h = bh & 15;
    BlockRef r; const size_t row0 = (size_t)b * SEQ;
    r.Q = Q + (row0 + (size_t)qb * QB) * RS + h * D; r.O = O + (row0 + (size_t)qb * QB) * RS + h * D;
    r.K = K + row0 * RS + h * D; r.V = V + row0 * RS + h * D; r.P0 = qb * QB;
    r.bt = MODE == 0 ? bt + (size_t)bh * SEQ : bt + h * NREL;
    if (MODE == 0) r.jl = jtab[bh * 16 + qb]; else { const int j = (r.P0 >> 6) - 8; r.jl = j > 0 ? j : 0; }
    return r;
}
template <int MODE>
__device__ __forceinline__ void attn_phase(char* lds, int vcu, int G, const GAS bf16_t* Q, const GAS bf16_t* K, const GAS bf16_t* V, GAS bf16_t* O, const GAS float* bt, const GAS int* jtab) {
    asm volatile("" : "+s"(Q), "+s"(K), "+s"(V), "+s"(O), "+s"(bt), "+s"(vcu), "+s"(jtab));
    const int total = BATCH * NH * 16;
    int nblk = 0; for (int L = vcu; L < total; L += G) ++nblk;
    if (nblk == 0) return;
    BlockRef cur = block_ref<MODE>(0, vcu, G, Q, K, V, O, bt, jtab);
    Seam S;
    attn_prime<MODE>(cur, lds, S);
    for (int n = 0; n < nblk; ++n) {
        const bool last = (n + 1 == nblk);
        const BlockRef nxt = last ? cur : block_ref<MODE>(n + 1, vcu, G, Q, K, V, O, bt, jtab);
        attn_block<MODE>(cur, nxt, lds, S);
        cur = nxt;
    }
}
}


#define XB_TMO      128
#define XB_XCNT(j)  (256  + 64 * (j))
#define XB_XSUB(j)  (1280 + 64 * (j))
#define XB_XGEN(j)  (2304 + 64 * (j))
#define XB_TOP      3328
#define XB_TOPGEN   3392
#define XCD_BAR_WORDS 3456
#define XB_SPIN_CAP (1u << 18)
__device__ __forceinline__ unsigned xb_ld(unsigned* p)              { return __hip_atomic_load(p, __ATOMIC_RELAXED, __HIP_MEMORY_SCOPE_AGENT); }
__device__ __forceinline__ unsigned xb_add(unsigned* p, unsigned v) { return __hip_atomic_fetch_add(p, v, __ATOMIC_RELAXED, __HIP_MEMORY_SCOPE_AGENT); }
__device__ __forceinline__ unsigned xb_xcc_id() { return (unsigned)__builtin_amdgcn_s_getreg((3 << 11) | 20) & 0xFu; }
#define XB_SPIN(cond, bar) do { unsigned _sp = 0; while (cond) { __builtin_amdgcn_s_sleep(1); \
    if ((++_sp & 255u) == 0u) { if (xb_ld(&(bar)[XB_TMO])) break; if (_sp > XB_SPIN_CAP) { atomicAdd(&(bar)[XB_TMO], 1u); break; } } } } while (0)
struct XcdBarrier { unsigned* bar; unsigned x; volatile LAS unsigned* st; };
__device__ __forceinline__ XcdBarrier xcd_barrier_post(unsigned* bar, volatile LAS unsigned* st) {
    XcdBarrier b; b.bar = bar; b.x = xb_xcc_id(); b.st = st;
    if (threadIdx.x == 0) (void)xb_add(&bar[XB_XCNT(b.x)], 1u);
    return b;
}
__device__ __forceinline__ void xcd_barrier_complete(unsigned* bar, unsigned x, unsigned& nloc, unsigned& nx) {
    const unsigned G = gridDim.x * gridDim.y * gridDim.z;
    unsigned sum, cnt, mine, sp = 0u;
    for (;;) {
        sum = 0u; cnt = 0u; mine = 0u;
#pragma unroll
        for (unsigned j = 0; j < 16; ++j) { const unsigned c = xb_ld(&bar[XB_XCNT(j)]); sum += c; cnt += (c > 0u) ? 1u : 0u; mine = (j == x) ? c : mine; }
        if (sum == G) break;
        __builtin_amdgcn_s_sleep(1);
        if ((++sp & 255u) == 0u) { if (xb_ld(&bar[XB_TMO])) break; if (sp > XB_SPIN_CAP) { atomicAdd(&bar[XB_TMO], 1u); break; } }
    }
    nloc = mine > 0u ? mine : 1u; nx = cnt > 0u ? cnt : 1u;
}
__device__ __forceinline__ void xcd_barrier(const XcdBarrier& b) {
    asm volatile("s_waitcnt vmcnt(0)" ::: "memory");
    __syncthreads();
    if (threadIdx.x == 0) {
        unsigned* bar = b.bar;
        __builtin_amdgcn_s_waitcnt(0);
        unsigned nloc = b.st[0], nx = b.st[1];
        if (nloc == 0u) { xcd_barrier_complete(bar, b.x, nloc, nx); b.st[0] = nloc; b.st[1] = nx; }
        const unsigned old = xb_add(&bar[XB_XSUB(b.x)], 1u);
        const unsigned gen = old / nloc;
        if (old + 1u == (gen + 1u) * nloc) {
            __builtin_amdgcn_fence(__ATOMIC_RELEASE, "agent");
            asm volatile("s_waitcnt vmcnt(0)" ::: "memory");
            const unsigned og = xb_add(&bar[XB_TOP], 1u);
            const unsigned tg = og / nx;
            if (og + 1u == (tg + 1u) * nx) xb_add(&bar[XB_TOPGEN], 1u);
            else XB_SPIN(xb_ld(&bar[XB_TOPGEN]) == tg, bar);
            __builtin_amdgcn_fence(__ATOMIC_ACQUIRE, "agent");
            xb_add(&bar[XB_XGEN(b.x)], 1u);
            asm volatile("s_waitcnt vmcnt(0)" ::: "memory");
        } else {
            XB_SPIN(xb_ld(&bar[XB_XGEN(b.x)]) == gen, bar);
            __builtin_amdgcn_fence(__ATOMIC_ACQUIRE, "agent");
            asm volatile("s_waitcnt vmcnt(0)" ::: "memory");
        }
    }
    __syncthreads();
}

__device__ __forceinline__ float wave_sum(float v) {
#pragma unroll
    for (int o = 1; o < 64; o <<= 1) v += __shfl_xor(v, o);
    return v;
}
__device__ __forceinline__ unsigned f2bf(float f) { unsigned u = __builtin_bit_cast(unsigned, f); return (u + 0x7fffu + ((u >> 16) & 1u)) >> 16; }
__device__ __forceinline__ unsigned pk2(float lo, float hi) { return f2bf(lo) | (f2bf(hi) << 16); }
__device__ __forceinline__ void transpose_item(const GAS float* W, int K, int N, int ldn, const GAS float* gk, GAS bf16_t* WT, int row_off, LAS float* scr, int item, int nblk, int lane) {
    const int kb = item / nblk, nb = item - kb * nblk, k0 = 64 * kb, n0 = 32 * nb;
    const int n = n0 + (lane & 31);
    float wv[32];
#pragma unroll
    for (int i = 0; i < 32; ++i) { const int kk = 2 * i + (lane >> 5); wv[i] = 0.f; if (n < N) wv[i] = __builtin_nontemporal_load(W + (size_t)(k0 + kk) * ldn + n); }
#pragma unroll
    for (int i = 0; i < 32; ++i) { const int kk = 2 * i + (lane >> 5); float v = wv[i]; if (gk) v *= gk[k0 + kk]; scr[kk * 33 + (lane & 31)] = v; }
    LDS_WAIT(); asm volatile("" ::: "memory");
    const int c = lane & 7;
#pragma unroll
    for (int j = 0; j < 4; ++j) { const int nn = (lane >> 3) + 8 * j; const LAS float* s = scr + (8 * c) * 33 + nn;
        u32x4 o; o.x = pk2(s[0 * 33], s[1 * 33]); o.y = pk2(s[2 * 33], s[3 * 33]); o.z = pk2(s[4 * 33], s[5 * 33]); o.w = pk2(s[6 * 33], s[7 * 33]);
        *(GAS u32x4*)(WT + (size_t)(row_off + n0 + nn) * K + k0 + 8 * c) = o; }
    LDS_WAIT(); asm volatile("" ::: "memory");
}
__device__ __forceinline__ void rms_row(const GAS float* xrow, GAS bf16_t* orow, int lane) {
    asm volatile("" : "+v"(lane));
    const GAS f32x4* xr = (const GAS f32x4*)xrow + lane;
    f32x4 v[8]; float s = 0.f;
#pragma unroll
    for (int j = 0; j < 8; ++j) { v[j] = xr[64 * j]; s += (v[j][0] * v[j][0] + v[j][1] * v[j][1]) + (v[j][2] * v[j][2] + v[j][3] * v[j][3]); }
    const float r = rsqrtf(wave_sum(s) * (1.f / DM) + EPS);
    GAS u32x2* o8 = (GAS u32x2*)orow + lane;
#pragma unroll
    for (int j = 0; j < 8; ++j) { u32x2 w; w.x = pk2(v[j][0] * r, v[j][1] * r); w.y = pk2(v[j][2] * r, v[j][3] * r); o8[64 * j] = w; }
}

struct Args { const float* in[18]; float* out; unsigned char* ws; };
enum { I_X = 0, I_ANG, I_AWIN, I_ABF, I_AQG, I_AKG, I_AWOUT, I_MNG, I_W1, I_W2, I_KVNG, I_KVW, I_KVKG, I_BNG, I_BWQ, I_BQG, I_BREL, I_BWOUT };

__global__ void __launch_bounds__(512, 2) fwd_megakernel(Args a) {
    extern __shared__ __attribute__((aligned(16))) unsigned char lds[];
    cg::grid_group grid = cg::this_grid();
    LAS unsigned char* L = (LAS unsigned char*)lds;
    const int wave = __builtin_amdgcn_readfirstlane(threadIdx.x >> 6);
    const int G = gridDim.x, bx = blockIdx.x;
    const int vcu = (G % 8 == 0) ? (bx % 8) * (G / 8) + bx / 8 : bx;
    GAS unsigned char* ws = (GAS unsigned char*)a.ws;
    GAS float* LF = (GAS float*)(ws + WS_LF); GAS float* GT = (GAS float*)(ws + WS_GT); GAS int* JT = (GAS int*)(ws + WS_GT + 8192);
    GAS bf16_t* WIN = (GAS bf16_t*)(ws + WS_WIN); GAS bf16_t* WOA = (GAS bf16_t*)(ws + WS_WOA); GAS bf16_t* W1T = (GAS bf16_t*)(ws + WS_W1); GAS bf16_t* W2T = (GAS bf16_t*)(ws + WS_W2);
    GAS bf16_t* WKVQ = (GAS bf16_t*)(ws + WS_WKVQ); GAS bf16_t* WOB = (GAS bf16_t*)(ws + WS_WOB);
    GAS bf16_t* U2 = (GAS bf16_t*)(ws + WS_U2); GAS float* SSQ = (GAS float*)(ws + WS_SSQ);
    GAS bf16_t* U = (GAS bf16_t*)(ws + WS_U); GAS bf16_t* QKV = (GAS bf16_t*)(ws + WS_QKV); GAS bf16_t* HID = QKV;
    GAS float* out = (GAS float*)a.out;
#define IN(i) ((const GAS float*)a.in[i])
    const int gw = vcu * 8 + wave, NGW = G * 8;
    if (threadIdx.x < 4) ((LAS unsigned*)(L + BARW_OFF))[threadIdx.x] = 0u;
    __syncthreads();
    const XcdBarrier xbar = xcd_barrier_post((unsigned*)a.ws, (volatile LAS unsigned*)(L + BARW_OFF));
#define GRID_BAR() xcd_barrier(xbar)

    for (int rep_ = 0; rep_ < (PROBE_REPEAT == 1 ? 2 : 1); ++rep_) {
        int tid = threadIdx.x; asm volatile("" : "+v"(tid)); const int lane = tid & 63;
        LAS float* scr = (LAS float*)(L + wave * 16384);
        constexpr int I0 = 32 * 200, I1 = 32 * 64, I2 = 32 * 256, I3 = 128 * 64, I4 = 32 * 128, I5 = 32 * 64, I6 = 32 * 64;
        constexpr int NITEMS = I0 + I1 + 2 * I2 + 2 * I3 + I4 + I5 + I6;
        for (int it = gw; it < NITEMS; it += NGW) {
            int r = it;
            if (r < I0) { transpose_item(IN(I_AWIN), DM, 3 * DM + NH, 3 * DM + NH, IN(I_ANG), WIN, 0, scr, r, 200, lane); continue; } r -= I0;
            if (r < I1) { transpose_item(IN(I_AWOUT), DM, DM, DM, nullptr, WOA, 0, scr, r, 64, lane); continue; } r -= I1;
            if (r < I2) { transpose_item(IN(I_W1), DM, FF, FF, IN(I_MNG), W1T, 0, scr, r, 256, lane); continue; } r -= I2;
            if (r < I2) { transpose_item(IN(I_W1) + (size_t)DM * FF, DM, FF, FF, IN(I_MNG) + DM, W1T + (size_t)FF * DM, 0, scr, r, 256, lane); continue; } r -= I2;
            if (r < I3) { transpose_item(IN(I_W2), FF, DM, DM, nullptr, W2T, 0, scr, r, 64, lane); continue; } r -= I3;
            if (r < I3) { transpose_item(IN(I_W2) + (size_t)FF * DM, FF, DM, DM, nullptr, W2T + (size_t)DM * FF, 0, scr, r, 64, lane); continue; } r -= I3;
            if (r < I4) { transpose_item(IN(I_KVW), DM, 2 * DM, 2 * DM, IN(I_KVNG), WKVQ, 0, scr, r, 128, lane); continue; } r -= I4;
            if (r < I5) { transpose_item(IN(I_BWQ), DM, DM, DM, IN(I_BNG), WKVQ, 2 * DM, scr, r, 64, lane); continue; } r -= I5;
            transpose_item(IN(I_BWOUT), DM, DM, DM, nullptr, WOB, 0, scr, r, 64, lane);
        }
        for (int m = gw; m < M; m += NGW) rms_row(IN(I_X) + (size_t)m * DM, U + (size_t)m * DM, lane);
        if (bx == 0 && tid < HD) { GT[tid] = IN(I_AQG)[tid]; GT[HD + tid] = IN(I_AKG)[tid]; GT[2 * HD + tid] = 1.f;
            GT[3 * HD + tid] = IN(I_KVKG)[tid]; GT[4 * HD + tid] = 1.f; GT[5 * HD + tid] = IN(I_BQG)[tid]; }
    }
    grid.sync();

    {
        pg8::Gemm g{U, WIN, M, NIN_A, DM}; pg8::StaticOrder S; S.init(M, NIN_A, G, bx);
        pg8::EpiQKV E{QKV, GT, 3, LF, IN(I_ABF), nullptr, (LAS float*)(L + XCH_OFF)};
#ifndef NO_EPIQKV_1
        pg8::gemm_phase<pg8::EpiQKV>(L, g, S, E);
#endif
    }
    GRID_BAR();

    if (bx < BATCH * NH) {
        int tid = threadIdx.x; asm volatile("" : "+v"(tid)); const int lane = tid & 63;
        GAS float* p = LF + (size_t)bx * SEQ + tid * 8;
        f32x4 v0 = *(const GAS f32x4*)p, v1 = *(const GAS f32x4*)(p + 4);
        v0[1] += v0[0]; v0[2] += v0[1]; v0[3] += v0[2]; v1[0] += v0[3]; v1[1] += v1[0]; v1[2] += v1[1]; v1[3] += v1[2];
        const float tot = v1[3]; float x = tot;
#pragma unroll
        for (int o = 1; o < 64; o <<= 1) { const float t = __shfl_up(x, o); if (lane >= o) x += t; }
        LAS float* wt = (LAS float*)L;
        LAS float* cs = (LAS float*)(L + 256);
        if (lane == 63) wt[wave] = x;
        float gq = 0.f, gk = 0.f;
        if (tid < 64) { gq = fmaxf(fabsf(GT[tid]), fabsf(GT[tid + 64])); gk = fmaxf(fabsf(GT[HD + tid]), fabsf(GT[HD + tid + 64]));
#pragma unroll
            for (int o = 1; o < 64; o <<= 1) { gq = fmaxf(gq, __shfl_xor(gq, o)); gk = fmaxf(gk, __shfl_xor(gk, o)); }
            if (tid == 0) wt[8] = 2.f * 1.02f * RSC * gq * gk + 30.f; }
        __syncthreads();
        float off = x - tot;
        for (int w = 0; w < wave; ++w) off += wt[w];
        v0 = v0 + off; v1 = v1 + off;
        *(GAS f32x4*)p = v0; *(GAS f32x4*)(p + 4) = v1;
        *(LAS f32x4*)(cs + tid * 8) = v0; *(LAS f32x4*)(cs + tid * 8 + 4) = v1;
        __syncthreads();
        if (tid < 16) { const int P0 = tid * 256; const float cq = cs[P0], T = wt[8]; int t = 0;
            while (t < (P0 >> 6) && cq - cs[64 * t + 63] < -T) ++t;
            JT[bx * 16 + tid] = t; }
    }
    GRID_BAR();

#ifndef NO_ATT0
    att::attn_phase<0>((char*)lds, vcu, G, QKV, QKV + SEG, QKV + 2 * SEG, U, LF, JT);
#endif
#if PROBE_REPEAT == 3
    __syncthreads(); att::attn_phase<0>((char*)lds, vcu, G, QKV, QKV + SEG, QKV + 2 * SEG, U, LF, JT);
#endif
    GRID_BAR();

    {
        pg8::Gemm g{U, WOA, M, DM, DM}; pg8::StaticOrder S; S.init(M, DM, G, bx);
        pg8::EpiResid E{IN(I_X), nullptr, nullptr, U2, SSQ, (LAS float*)(L + XCH_OFF)};
#ifndef NO_EPIRESID_1
        pg8::gemm_phase<pg8::EpiResid>(L, g, S, E);
#endif
    }
    GRID_BAR();

#define MLP_BLOCK(layer, SSQ_IN, OUTF, HB_OUT, SSQ_OUT) do { \
        { pg8::Gemm g{U2, W1T + (size_t)(layer) * FF * DM, M, FF, DM}; pg8::StaticOrder S; S.init(M, FF, G, bx); \
          pg8::EpiRelu2 E{HID, SSQ_IN}; \
          pg8::gemm_phase<pg8::EpiRelu2>(L, g, S, E); \
          if (PROBE_REPEAT == 6 && (layer) == 0) { __syncthreads(); pg8::gemm_phase<pg8::EpiRelu2>(L, g, S, E); } } \
        GRID_BAR(); \
        { pg8::Gemm g{HID, W2T + (size_t)(layer) * DM * FF, M, DM, FF}; pg8::StaticOrder S; S.init(M, DM, G, bx); \
          pg8::EpiResid E{nullptr, U2, OUTF, HB_OUT, SSQ_OUT, (LAS float*)(L + XCH_OFF)}; \
          pg8::gemm_phase<pg8::EpiResid>(L, g, S, E); } } while (0)
    MLP_BLOCK(0, SSQ, (GAS float*)nullptr, U2, SSQ + (size_t)8 * M);
    GRID_BAR();
    {
        pg8::Gemm g{U2, WKVQ, M, NIN_B, DM}; pg8::StaticOrder S; S.init(M, NIN_B, G, bx);
        pg8::EpiQKV E{QKV, GT + 3 * HD, 5, nullptr, nullptr, SSQ + (size_t)8 * M, (LAS float*)(L + XCH_OFF)};
        pg8::gemm_phase<pg8::EpiQKV>(L, g, S, E);
    }
    GRID_BAR();
    att::attn_phase<1>((char*)lds, vcu, G, QKV + 2 * SEG, QKV, QKV + SEG, U, IN(I_BREL), JT);
#if PROBE_REPEAT == 10
    __syncthreads(); att::attn_phase<1>((char*)lds, vcu, G, QKV + 2 * SEG, QKV, QKV + SEG, U, IN(I_BREL), JT);
#endif
    GRID_BAR();
    {
        pg8::Gemm g{U, WOB, M, DM, DM}; pg8::StaticOrder S; S.init(M, DM, G, bx);
        pg8::EpiResid E{nullptr, U2, nullptr, U2, SSQ + (size_t)16 * M, (LAS float*)(L + XCH_OFF)};
        pg8::gemm_phase<pg8::EpiResid>(L, g, S, E);
    }
    GRID_BAR();
    MLP_BLOCK(1, SSQ + (size_t)16 * M, out, (GAS bf16_t*)nullptr, (GAS float*)nullptr);
#undef MLP_BLOCK
}

extern "C" void kernel_launch(void* const* d_in, const int* in_sizes, int n_in, void* d_out, int out_size, void* d_ws, size_t ws_size, hipStream_t stream) {
    static int grid = 0;
    if (grid == 0) {
        if (n_in != 18 || in_sizes[0] != M * DM || out_size != M * DM || ws_size < WS_END) {
            fprintf(stderr, "kernel_launch: shape mismatch (n_in %d in0 %d out %d ws %zu)\n", n_in, n_in > 0 ? in_sizes[0] : -1, out_size, ws_size); grid = -1; return; }
        int dev = 0, cus = 0, per_cu = 0;
        (void)hipGetDevice(&dev);
        if (hipDeviceGetAttribute(&cus, hipDeviceAttributeMultiprocessorCount, dev) != hipSuccess || cus <= 0) cus = 256;
        if (hipFuncSetAttribute((const void*)fwd_megakernel, hipFuncAttributeMaxDynamicSharedMemorySize, LDS_BYTES) != hipSuccess) { fprintf(stderr, "kernel_launch: hipFuncSetAttribute failed\n"); grid = -1; return; }
        if (hipOccupancyMaxActiveBlocksPerMultiprocessor(&per_cu, (const void*)fwd_megakernel, 512, LDS_BYTES) != hipSuccess || per_cu < 1) { fprintf(stderr, "kernel_launch: occupancy query says %d\n", per_cu); per_cu = 1; }
        (void)hipGetLastError();
        grid = cus * per_cu;
    }
    if (grid < 0) return;
    if (hipMemsetAsync(d_ws, 0, 16384, stream) != hipSuccess) { fprintf(stderr, "kernel_launch: memset failed\n"); return; }
    Args a{};
    for (int i = 0; i < 18; ++i) a.in[i] = (const float*)d_in[i];
    a.out = (float*)d_out; a.ws = (unsigned char*)d_ws;
    void* args[] = {&a};
    hipError_t e = hipLaunchCooperativeKernel((const void*)fwd_megakernel, dim3(grid), dim3(512), args, LDS_BYTES, stream);
    if (e != hipSuccess) fprintf(stderr, "kernel_launch: cooperative launch failed: %s (grid %d)\n", hipGetErrorString(e), grid);
}
```

```cpp
#include <hip/hip_runtime.h>
#include <hip/hip_cooperative_groups.h>
#include <cstdio>
#include <cstdint>
namespace cg = cooperative_groups;

#ifndef STAGGER_TICKS
#define STAGGER_TICKS 0
#endif
#ifndef PROBE_REPEAT
#define PROBE_REPEAT 0
#endif
#define LAS __attribute__((address_space(3)))
#define GAS __attribute__((address_space(1)))
typedef unsigned short bf16_t;
typedef short bf16x8 __attribute__((ext_vector_type(8)));
typedef short s16x4 __attribute__((ext_vector_type(4)));
typedef float f32x4 __attribute__((ext_vector_type(4)));
typedef float f32x16 __attribute__((ext_vector_type(16)));
typedef unsigned u32x4 __attribute__((ext_vector_type(4)));
typedef unsigned u32x2 __attribute__((ext_vector_type(2)));

constexpr int BATCH = 8, SEQ = 4096, DM = 2048, NH = 16, HD = 128, FF = 8192, NREL = 320;
constexpr int M = BATCH * SEQ;
constexpr int NIN_A = 3 * DM + 256;
constexpr int NIN_B = 3 * DM;
constexpr float EPS = 1e-6f;
constexpr float SCALE = 0.08838834764831845f;
constexpr float RSC = 11.313708498984761f;

constexpr size_t MiB = 1u << 20;
constexpr size_t WS_GT = 512 * 1024;
constexpr size_t WS_LF = 1 * MiB;
constexpr size_t WS_WIN = 4 * MiB;
constexpr size_t WS_WOA = 29 * MiB;
constexpr size_t WS_W1 = 37 * MiB;
constexpr size_t WS_W2 = 101 * MiB;
constexpr size_t WS_WKVQ = 165 * MiB;
constexpr size_t WS_WOB = 189 * MiB;
constexpr size_t WS_U = 200 * MiB;
constexpr size_t WS_QKV = 328 * MiB;
constexpr size_t SEG = (size_t)M * DM;
constexpr size_t WS_U2 = 840 * MiB;
constexpr size_t WS_SSQ = 968 * MiB;
constexpr size_t WS_END = 972 * MiB;

constexpr int RING_BYTES = 131072;
constexpr int XCH_OFF = RING_BYTES;
constexpr int BARW_OFF = XCH_OFF + 8192;
constexpr int LDS_BYTES = 147456;

__device__ __forceinline__ unsigned cvt_pk_bf16(float lo, float hi) { unsigned r; asm volatile("v_cvt_pk_bf16_f32 %0, %1, %2" : "=v"(r) : "v"(lo), "v"(hi)); return r; }
#define LDS_WAIT() asm volatile("s_waitcnt lgkmcnt(0)" ::: "memory")

namespace pg8 {
constexpr int BM = 256, BK = 64, HALF = 128, HTB = HALF * BK * 2, NXCD = 8, WGM = 8;
__host__ __device__ __forceinline__ int lds_byte(int r, int c) { const int st = (r >> 4) * 2 + (c >> 5), rr = r & 15, cc = c & 31, ob = rr * 64 + cc * 2; return st * 1024 + (ob ^ (((ob >> 9) & 1) << 5)); }
__host__ __device__ __forceinline__ void stage_rc(int b, int& R, int& C) { const int st = b / 1024, sb = b % 1024, swz = sb ^ (((sb >> 9) & 1) << 5); R = (st >> 1) * 16 + swz / 64; C = (st & 1) * 32 + (swz % 64) / 2; }
__host__ __device__ __forceinline__ int perm32(int rho) { const int n = rho >> 4, i = rho & 15; return 8 * (i >> 2) + 4 * n + (i & 3); }

struct Unit { int pm, pn; };
struct Gemm { const GAS bf16_t* A; const GAS bf16_t* Bt; int M, N, K; };

struct StaticOrder {
    int nM, nN, nwg, G, c;
    __device__ void init(int M_, int N_, int G_, int c_) { nM = M_ / BM; nN = N_ / BM; nwg = nM * nN; G = G_; c = c_; }
    __device__ bool next(int i, Unit& u) const {
        const long L = (long)i * G + c; if (L >= nwg) return false;
        int wgid = (int)L; { const int q = nwg / NXCD, r = nwg % NXCD, xcd = wgid % NXCD, off = wgid / NXCD; wgid = (xcd < r ? xcd * (q + 1) : r * (q + 1) + (xcd - r) * q) + off; }
        const int nig = WGM * nN, gid = wgid / nig, fm = gid * WGM, gsz = (nM - fm) < WGM ? (nM - fm) : WGM;
        u.pm = fm + ((wgid % nig) % gsz); u.pn = (wgid % nig) / gsz; return true;
    }
};


struct EpiQKV {
    static constexpr bool PERM = true;
    GAS bf16_t* O;
    const GAS float* gt; int normmask;
    GAS float* logf; const GAS float* bfg;
    const GAS float* ssq;
    LAS float* xch;
    __device__ __forceinline__ void operator()(const f32x4 (&acc)[2][2][4][2], const Unit& u, int wr, int wc, int fr, int fq) const {
        const int t = u.pn >> 3;
        const int row0 = u.pm * BM + wr * 64 + fr;
        if (t == 3) {
            if (wc == 0 && fq < 2) {
#pragma unroll
                for (int ai = 0; ai < 2; ++ai)
#pragma unroll
                    for (int m = 0; m < 4; ++m) { const int row = row0 + ai * HALF + m * 16; const int b = row >> 12, s = row & 4095;
                        float rw = 1.f;
                        if (ssq) { const GAS f32x4* pp = (const GAS f32x4*)(ssq + (size_t)row * 8); const f32x4 p = pp[0], q = pp[1];
                            rw = rsqrtf((((p[0] + p[1]) + (p[2] + p[3])) + ((q[0] + q[1]) + (q[2] + q[3]))) * (1.f / DM) + EPS); }
#pragma unroll
                        for (int n = 0; n < 2; ++n)
#pragma unroll
                            for (int j = 0; j < 4; ++j) { const int c = 8 * fq + 4 * n + j; const float z = acc[ai][0][m][n][j] * rw + bfg[c];
                                const float lf = fminf(z, 0.f) - __logf(1.f + __expf(-fabsf(z)));
                                logf[((size_t)(b * NH + c)) * SEQ + s] = lf; } }
            }
            return;
        }
        const GAS float* gp = gt + t * HD; const bool g = (normmask >> t) & 1;
        GAS bf16_t* base = O + (size_t)t * SEG;
        const int colt = (u.pn & 7) * BM + wc * 32 + 8 * fq;
        f32x4 gv0 = (f32x4){1.f, 1.f, 1.f, 1.f}, gv1 = gv0;
        float rw2a[2][4];
        if (ssq) {
#pragma unroll
            for (int ai = 0; ai < 2; ++ai)
#pragma unroll
                for (int m = 0; m < 4; ++m) { const GAS float* pp = ssq + (size_t)(row0 + ai * HALF + m * 16) * 8 + 2 * fq; rw2a[ai][m] = pp[0] + pp[1]; }
#pragma unroll
            for (int ai = 0; ai < 2; ++ai)
#pragma unroll
                for (int m = 0; m < 4; ++m) { float st = rw2a[ai][m]; st += __shfl_xor(st, 16); st += __shfl_xor(st, 32); rw2a[ai][m] = 1.f / (st * (1.f / DM) + EPS); } }
        if (g) {
#pragma unroll
            for (int ai = 0; ai < 2; ++ai)
#pragma unroll
                for (int m = 0; m < 4; ++m)
#pragma unroll
                    for (int bj = 0; bj < 2; ++bj) { const f32x4 a = acc[ai][bj][m][0], b = acc[ai][bj][m][1];
                        float s = (a[0] * a[0] + a[1] * a[1]) + (a[2] * a[2] + a[3] * a[3]) + (b[0] * b[0] + b[1] * b[1]) + (b[2] * b[2] + b[3] * b[3]);
                        s += __shfl_xor(s, 16); s += __shfl_xor(s, 32);
                        if (fq == 0) xch[((ai * HALF + wr * 64 + m * 16 + fr) * 2 + bj) * 4 + wc] = s; }
            LDS_WAIT(); __builtin_amdgcn_s_barrier(); asm volatile("" ::: "memory");
            int go = wc * 32 + 8 * fq; asm volatile("" : "+v"(go));
            gv0 = *(const GAS f32x4*)(gp + go); gv1 = *(const GAS f32x4*)(gp + go + 4);
        }
#pragma unroll
        for (int ai = 0; ai < 2; ++ai)
#pragma unroll
            for (int m = 0; m < 4; ++m) { GAS bf16_t* rowp = base + (size_t)(row0 + ai * HALF + m * 16) * DM + colt;
                float r0 = 1.f, r1 = 1.f, rw = 1.f, rw2 = 1.f;
                if (ssq) { rw2 = rw2a[ai][m]; rw = sqrtf(rw2); }
                if (g) { const LAS f32x4* pp = (const LAS f32x4*)(xch + ((ai * HALF + wr * 64 + m * 16 + fr) * 2) * 4); const f32x4 p = pp[0], q = pp[1];
                    r0 = rsqrtf(((p[0] + p[1]) + (p[2] + p[3])) * rw2 * (1.f / 128.f) + EPS); r1 = rsqrtf(((q[0] + q[1]) + (q[2] + q[3])) * rw2 * (1.f / 128.f) + EPS); }
                r0 *= rw; r1 *= rw;
#pragma unroll
                for (int bj = 0; bj < 2; ++bj) { const float rr = bj ? r1 : r0; const f32x4 v0 = acc[ai][bj][m][0] * rr * gv0, v1 = acc[ai][bj][m][1] * rr * gv1;
                    u32x4 w; w.x = cvt_pk_bf16(v0[0], v0[1]); w.y = cvt_pk_bf16(v0[2], v0[3]); w.z = cvt_pk_bf16(v1[0], v1[1]); w.w = cvt_pk_bf16(v1[2], v1[3]);
                    *(GAS u32x4*)(rowp + bj * HALF) = w; } }
    }
};
struct EpiResid {
    static constexpr bool PERM = false;
    const GAS float* xf; const GAS bf16_t* hin; GAS float* outf; GAS bf16_t* hb; GAS float* ssq;
    LAS float* xch;
    __device__ __forceinline__ void operator()(const f32x4 (&acc)[2][2][4][2], const Unit& u, int wr, int wc, int fr, int fq) const {
        const int row0 = u.pm * BM + wr * 64 + fr, col0 = u.pn * BM + wc * 32 + 4 * fq;
#pragma unroll
        for (int ai = 0; ai < 2; ++ai) {
            u32x2 hw[4][2][2];
            if (!xf) {
#pragma unroll
                for (int m = 0; m < 4; ++m)
#pragma unroll
                    for (int bj = 0; bj < 2; ++bj)
#pragma unroll
                        for (int n = 0; n < 2; ++n) hw[m][bj][n] = *(const GAS u32x2*)(hin + (size_t)(row0 + ai * HALF + m * 16) * DM + col0 + bj * HALF + n * 16);
            }
#pragma unroll
            for (int mh = 0; mh < 2; ++mh) {
                f32x4 xs[2][2][2];
                if (xf) {
#pragma unroll
                    for (int mm = 0; mm < 2; ++mm)
#pragma unroll
                        for (int bj = 0; bj < 2; ++bj)
#pragma unroll
                            for (int n = 0; n < 2; ++n) xs[mm][bj][n] = *(const GAS f32x4*)(xf + (size_t)(row0 + ai * HALF + (2 * mh + mm) * 16) * DM + col0 + bj * HALF + n * 16);
                }
#pragma unroll
                for (int mm = 0; mm < 2; ++mm) { const int m = 2 * mh + mm; const int row = row0 + ai * HALF + m * 16; const size_t off = (size_t)row * DM + col0;
                    float sq = 0.f;
#pragma unroll
                    for (int bj = 0; bj < 2; ++bj)
#pragma unroll
                        for (int n = 0; n < 2; ++n) { f32x4 b4;
                            if (xf) b4 = xs[mm][bj][n];
                            else { const u32x2 w = hw[m][bj][n]; b4 = (f32x4){__uint_as_float(w.x << 16), __uint_as_float(w.x & 0xffff0000u), __uint_as_float(w.y << 16), __uint_as_float(w.y & 0xffff0000u)}; }
                            const f32x4 v = acc[ai][bj][m][n] + b4;
                            if (outf) __builtin_nontemporal_store(v, (GAS f32x4*)(outf + off + bj * HALF + n * 16));
                            if (hb) { u32x2 w; w.x = cvt_pk_bf16(v[0], v[1]); w.y = cvt_pk_bf16(v[2], v[3]); *(GAS u32x2*)(hb + off + bj * HALF + n * 16) = w;
                                sq += (v[0] * v[0] + v[1] * v[1]) + (v[2] * v[2] + v[3] * v[3]); } }
                    if (hb) { sq += __shfl_xor(sq, 16); sq += __shfl_xor(sq, 32); if (fq == 0) xch[(ai * HALF + wr * 64 + m * 16 + fr) * 4 + wc] = sq; }
                }
                if (xf) asm volatile("" ::: "memory");
            }
            asm volatile("" ::: "memory");
        }
        if (hb) { LDS_WAIT(); __builtin_amdgcn_s_barrier(); asm volatile("" ::: "memory");
            const int t = wr * 256 + wc * 64 + fq * 16 + fr;
            if (t < 256) { const f32x4 p = *(const LAS f32x4*)(xch + t * 4); ssq[(size_t)(u.pm * BM + t) * 8 + u.pn] = (p[0] + p[1]) + (p[2] + p[3]); } }
    }
};
struct EpiRelu2 {
    static constexpr bool PERM = true;
    GAS bf16_t* O; const GAS float* ssq;
    __device__ __forceinline__ void operator()(const f32x4 (&acc)[2][2][4][2], const Unit& u, int wr, int wc, int fr, int fq) const {
        const int row0 = u.pm * BM + wr * 64 + fr, col0 = u.pn * BM + wc * 32 + 8 * fq;
        float sp[2][4];
#pragma unroll
        for (int ai = 0; ai < 2; ++ai)
#pragma unroll
            for (int m = 0; m < 4; ++m) { const GAS float* pp = ssq + (size_t)(row0 + ai * HALF + m * 16) * 8 + 2 * fq; sp[ai][m] = pp[0] + pp[1]; }
#pragma unroll
        for (int ai = 0; ai < 2; ++ai)
#pragma unroll
            for (int m = 0; m < 4; ++m) { GAS bf16_t* rowp = O + (size_t)(row0 + ai * HALF + m * 16) * FF + col0;
                float st = sp[ai][m]; st += __shfl_xor(st, 16); st += __shfl_xor(st, 32);
                const float r2 = 1.f / (st * (1.f / DM) + EPS);
#pragma unroll
                for (int bj = 0; bj < 2; ++bj) { f32x4 v0 = acc[ai][bj][m][0], v1 = acc[ai][bj][m][1];
#pragma unroll
                    for (int j = 0; j < 4; ++j) { v0[j] = fmaxf(v0[j], 0.f); v1[j] = fmaxf(v1[j], 0.f); }
                    v0 = v0 * v0 * r2; v1 = v1 * v1 * r2;
                    u32x4 w; w.x = cvt_pk_bf16(v0[0], v0[1]); w.y = cvt_pk_bf16(v0[2], v0[3]); w.z = cvt_pk_bf16(v1[0], v1[1]); w.w = cvt_pk_bf16(v1[2], v1[3]);
                    *(GAS u32x4*)(rowp + bj * HALF) = w; } }
    }
};

template <class Epi>
__device__ __forceinline__ void gemm_phase(LAS unsigned char* lds, Gemm g, const StaticOrder& S, const Epi& E) {
    int tid = threadIdx.x; asm volatile("" : "+v"(tid));
    asm volatile("" : "+s"(g.A), "+s"(g.Bt));
    const int wid = __builtin_amdgcn_readfirstlane(tid >> 6), lane = tid & 63, wr = wid >> 2, wc = wid & 3, fr = lane & 15, fq = lane >> 4;
    const int K = g.K, nt = K / BK;
    unsigned voffA[2], voffB[2];
#pragma unroll
    for (int i = 0; i < 2; ++i) { int R, C; stage_rc(tid * 16 + i * 8192, R, C); const int Rb = Epi::PERM ? ((R & ~31) + perm32(R & 31)) : R;
        voffA[i] = (unsigned)(R * K + C) * 2u; voffB[i] = (unsigned)(Rb * K + C) * 2u; }
    const size_t kstep = (size_t)(BK * 2);
    const size_t hstep = (size_t)HALF * K * 2;
    const size_t tstep = 2 * hstep;
    const unsigned ldsw = (unsigned)wid * 1024u;
    const int aoff = lds_byte(wr * 64 + fr, fq * 8), boff = lds_byte(wc * 32 + fr, fq * 8);
#define PG8_SA(b, h) (((b) * 2 + (h)) * HTB)
#define PG8_SB(b, h) ((4 + (b) * 2 + (h)) * HTB)
#define PG8_STAGE(bufoff, gbase, voff) do { _Pragma("unroll") for (int _i = 0; _i < 2; ++_i) \
        __builtin_amdgcn_global_load_lds((const GAS unsigned*)((const GAS char*)(gbase) + (voff)[_i]), (LAS unsigned*)(lds + (bufoff) + ldsw + _i * 8192), 16, 0, 0); } while (0)
#define PG8_LDA(dst, b, h) do { _Pragma("unroll") for (int m = 0; m < 4; ++m) _Pragma("unroll") for (int k = 0; k < 2; ++k) dst[m][k] = *(const LAS bf16x8*)(lds + PG8_SA(b, h) + aoff + m * 2048 + k * 1024); } while (0)
#define PG8_LDB(dst, b, h) do { _Pragma("unroll") for (int n = 0; n < 2; ++n) _Pragma("unroll") for (int k = 0; k < 2; ++k) dst[n][k] = *(const LAS bf16x8*)(lds + PG8_SB(b, h) + boff + n * 2048 + k * 1024); } while (0)
#define PG8_MMA(ai, bj, At, Bt) do { __builtin_amdgcn_s_setprio(1); _Pragma("unroll") for (int m = 0; m < 4; ++m) _Pragma("unroll") for (int n = 0; n < 2; ++n) _Pragma("unroll") for (int k = 0; k < 2; ++k) \
        acc[ai][bj][m][n] = __builtin_amdgcn_mfma_f32_16x16x32_bf16(Bt[n][k], At[m][k], acc[ai][bj][m][n], 0, 0, 0); __builtin_amdgcn_s_setprio(0); } while (0)
#define PG8_WAIT_V(n) asm volatile("s_waitcnt vmcnt(" #n ")" ::: "memory")
#define PG8_WAIT_L(n) asm volatile("s_waitcnt lgkmcnt(" #n ")" ::: "memory")
#define PG8_BAR __builtin_amdgcn_s_barrier()
#define PG8_SCHED __builtin_amdgcn_sched_barrier(0)
    Unit cur, nxt; int ui = 0;
    if (!S.next(0, cur)) return;
    if (STAGGER_TICKS > 0 && (S.c & 1)) { const unsigned long long t0_ = __builtin_amdgcn_s_memrealtime(); while (__builtin_amdgcn_s_memrealtime() - t0_ < (unsigned long long)STAGGER_TICKS) __builtin_amdgcn_s_sleep(16); }
    f32x4 acc[2][2][4][2];
#pragma unroll
    for (int a = 0; a < 2; ++a)
#pragma unroll
        for (int b = 0; b < 2; ++b)
#pragma unroll
            for (int m = 0; m < 4; ++m)
#pragma unroll
                for (int n = 0; n < 2; ++n) acc[a][b][m][n] = (f32x4){0.f, 0.f, 0.f, 0.f};
    bf16x8 At[4][2], B0[2][2], B1[2][2];
    const GAS char* cA = (const GAS char*)g.A + (size_t)cur.pm * tstep; const GAS char* cB = (const GAS char*)g.Bt + (size_t)cur.pn * tstep;
    PG8_STAGE(PG8_SB(0, 0), cB, voffB); PG8_STAGE(PG8_SB(0, 1), cB + hstep, voffB); PG8_STAGE(PG8_SA(0, 0), cA, voffA); PG8_STAGE(PG8_SA(0, 1), cA + hstep, voffA);
    if (wr == 1) PG8_BAR;
    PG8_WAIT_V(2); PG8_BAR;
    PG8_STAGE(PG8_SB(1, 0), cB + kstep, voffB); PG8_STAGE(PG8_SA(1, 0), cA + kstep, voffA); PG8_STAGE(PG8_SB(1, 1), cB + hstep + kstep, voffB);
    PG8_WAIT_V(6); PG8_BAR;
    for (;;) {
        const bool has_next = S.next(ui + 1, nxt);
        const GAS char* nA = has_next ? (const GAS char*)g.A + (size_t)nxt.pm * tstep : cA; const GAS char* nB = has_next ? (const GAS char*)g.Bt + (size_t)nxt.pn * tstep : cB;
        for (int t = 0; t < nt; t += 2) {
            const bool last = (t == nt - 2);
            const GAS char* a1 = cA + (size_t)(t + 1) * kstep;
            const GAS char* a2 = last ? nA : cA + (size_t)(t + 2) * kstep; const GAS char* b2 = last ? nB : cB + (size_t)(t + 2) * kstep;
            const GAS char* a3 = a2 + kstep; const GAS char* b3 = b2 + kstep;
            PG8_LDB(B0, 0, 0); PG8_LDB(B1, 0, 1); PG8_SCHED; PG8_LDA(At, 0, 0); PG8_STAGE(PG8_SA(1, 1), a1 + hstep, voffA);
            PG8_WAIT_V(8); PG8_WAIT_L(0); PG8_BAR; PG8_MMA(0, 0, At, B0); PG8_MMA(0, 1, At, B1); PG8_BAR; PG8_SCHED;
            PG8_LDA(At, 0, 1); PG8_STAGE(PG8_SB(0, 0), b2, voffB); PG8_STAGE(PG8_SB(0, 1), b2 + hstep, voffB); PG8_STAGE(PG8_SA(0, 0), a2, voffA);
            PG8_WAIT_V(8); PG8_WAIT_L(0); PG8_BAR; PG8_MMA(1, 0, At, B0); PG8_MMA(1, 1, At, B1); PG8_BAR; PG8_SCHED;
            PG8_LDB(B0, 1, 0); PG8_LDB(B1, 1, 1); PG8_SCHED; PG8_LDA(At, 1, 0); PG8_STAGE(PG8_SA(0, 1), a2 + hstep, voffA);
            PG8_WAIT_V(8); PG8_WAIT_L(0); PG8_BAR; PG8_MMA(0, 0, At, B0); PG8_MMA(0, 1, At, B1); PG8_BAR; PG8_SCHED;
            PG8_LDA(At, 1, 1); PG8_STAGE(PG8_SB(1, 0), b3, voffB); PG8_STAGE(PG8_SB(1, 1), b3 + hstep, voffB); PG8_STAGE(PG8_SA(1, 0), a3, voffA);
            PG8_WAIT_V(8); PG8_WAIT_L(0); PG8_BAR; PG8_MMA(1, 0, At, B0); PG8_MMA(1, 1, At, B1); PG8_BAR; PG8_SCHED;
        }
        if (wr == 0) PG8_BAR;
        E(acc, cur, wr, wc, fr, fq);
        if (!has_next) break;
#pragma unroll
        for (int a = 0; a < 2; ++a)
#pragma unroll
            for (int b = 0; b < 2; ++b)
#pragma unroll
                for (int m = 0; m < 4; ++m)
#pragma unroll
                    for (int n = 0; n < 2; ++n) acc[a][b][m][n] = (f32x4){0.f, 0.f, 0.f, 0.f};
        cur = nxt; cA = nA; cB = nB; ++ui;
        if (wr == 1) PG8_BAR;
    }
    PG8_WAIT_V(0);
    PG8_BAR;
#undef PG8_SA
#undef PG8_SB
#undef PG8_STAGE
#undef PG8_LDA
#undef PG8_LDB
#undef PG8_MMA
#undef PG8_WAIT_V
#undef PG8_WAIT_L
#undef PG8_BAR
#undef PG8_SCHED
}
}

namespace att {
constexpr int D = 128, RS = 2048, NW = 8, QBLK = 32, KVBLK = 64, QB = NW * QBLK;
constexpr int SHM_V = KVBLK * D * 2, SHM_K = KVBLK * D * 2;
constexpr int OFF_WS = 2 * SHM_V + 2 * SHM_K;
constexpr int OFF_BIAS = OFF_WS + NW * 64 * 4;
constexpr int OFF_OST = 86016, OST_WAVE = 16 * 272;
constexpr int CST = 648;
constexpr float THR = 40.f;

#define KSWZ(row, colB) ((row) * 256 + ((colB) ^ (((row) & 7) << 4)))
#define SBAR() __builtin_amdgcn_sched_barrier(0)
__device__ __forceinline__ int v_st(int k, int c) { const int kk = (k & ~0xC) | ((k & 4) << 1) | ((k & 8) >> 1); return ((kk >> 3) * 4 + (c >> 5)) * 512 + ((kk & 7) * 32 + (c & 31)) * 2; }
__device__ __forceinline__ int v_rd_base(int lane) { return ((lane & 3) << 3) | (((lane >> 2) & 3) << 6) | (((lane >> 4) & 1) << 5) | (((lane >> 5) & 1) << 8); }
constexpr int v_rd_off(int d0, int ks, int half) { return d0 * 512 + ks * 4096 + half * 2048; }
__device__ __forceinline__ int crow(int r, int hi) { return (r & 3) + 8 * (r >> 2) + 4 * hi; }
__device__ __forceinline__ unsigned cvtpk(float lo, float hi) { unsigned r; asm volatile("v_cvt_pk_bf16_f32 %0, %1, %2" : "=v"(r) : "v"(lo), "v"(hi)); return r; }
__device__ __forceinline__ bf16x8 load8(const GAS bf16_t* p) { return *(const GAS bf16x8*)(p); }

__device__ __forceinline__ void mask_tile(f32x16& p0, f32x16& p1, int dq, unsigned W) {
    const float NEG = -__builtin_inff();
#pragma unroll
    for (int r = 0; r < 16; ++r) {
        const int c = (r & 3) + 8 * (r >> 2);
        if ((unsigned)(dq - c) >= W) p0[r] = NEG;
        if ((unsigned)(dq - c - 32) >= W) p1[r] = NEG;
    }
}
__device__ __forceinline__ void partialSM(f32x16& p0, f32x16& p1, float& m_reg, float& mn, float& alpha) {
    float pmax = p0[0];
#pragma unroll
    for (int r = 1; r < 16; ++r) pmax = fmaxf(pmax, p0[r]);
#pragma unroll
    for (int r = 0; r < 16; ++r) pmax = fmaxf(pmax, p1[r]);
    { auto rr = __builtin_amdgcn_permlane32_swap(__float_as_uint(pmax), __float_as_uint(pmax), false, false);
      pmax = fmaxf(__uint_as_float(rr[0]), __uint_as_float(rr[1])); }
    constexpr float C2 = 1.4426950408889634f * SCALE;
    if (__builtin_expect(__all((pmax - m_reg) * SCALE <= THR), 1)) { mn = m_reg; alpha = 1.f; }
    else { mn = fmaxf(m_reg, pmax); alpha = __builtin_amdgcn_exp2f((m_reg - mn) * C2); m_reg = mn; }
    const float mnL = -mn * C2;
#pragma unroll
    for (int r = 0; r < 16; ++r) p0[r] = fmaf(p0[r], C2, mnL);
#pragma unroll
    for (int r = 0; r < 16; ++r) p1[r] = fmaf(p1[r], C2, mnL);
#pragma unroll
    for (int r = 0; r < 16; ++r) p0[r] = __builtin_amdgcn_exp2f(p0[r]);
}
__device__ __forceinline__ void finishSM(f32x16& p0, f32x16& p1, float alpha, float& l_reg, bf16x8& pa0, bf16x8& pa1, bf16x8& pa2, bf16x8& pa3) {
#pragma unroll
    for (int r = 0; r < 16; ++r) p1[r] = __builtin_amdgcn_exp2f(p1[r]);
    float ps = 0;
#pragma unroll
    for (int r = 0; r < 16; ++r) ps += p0[r];
#pragma unroll
    for (int r = 0; r < 16; ++r) ps += p1[r];
    { auto rr = __builtin_amdgcn_permlane32_swap(__float_as_uint(ps), __float_as_uint(ps), false, false);
      ps = __uint_as_float(rr[0]) + __uint_as_float(rr[1]); }
    l_reg = l_reg * alpha + ps;
#define PK4(P, B_, OUT) do { unsigned a0 = cvtpk(P[B_+0], P[B_+1]), a1 = cvtpk(P[B_+2], P[B_+3]);                          \
        unsigned b0 = cvtpk(P[B_+4], P[B_+5]), b1 = cvtpk(P[B_+6], P[B_+7]);                                             \
        auto r0 = __builtin_amdgcn_permlane32_swap(a0, b0, false, false); auto r1 = __builtin_amdgcn_permlane32_swap(a1, b1, false, false); \
        u32x4 w = {r0[0], r1[0], r0[1], r1[1]}; OUT = *reinterpret_cast<bf16x8*>(&w); } while (0)
    PK4(p0, 0, pa0); PK4(p0, 8, pa1); PK4(p1, 0, pa2); PK4(p1, 8, pa3);
#undef PK4
}
template <int KB, bool SK>
__device__ __forceinline__ void qkt(f32x16& p0, f32x16& p1, const char* K_lds, int r32, int hi, const bf16x8* qr, bool act, const char* bp) {
    if (SK && !act) { const float NEG = -__builtin_inff();
#pragma unroll
        for (int r = 0; r < 16; ++r) { p0[r] = NEG; p1[r] = NEG; } return; }
    { const f32x4 b0 = *(const f32x4*)(bp), b1 = *(const f32x4*)(bp + 32), b2 = *(const f32x4*)(bp + 64), b3 = *(const f32x4*)(bp + 96);
      const f32x4 b4 = *(const f32x4*)(bp + 128), b5 = *(const f32x4*)(bp + 160), b6 = *(const f32x4*)(bp + 192), b7 = *(const f32x4*)(bp + 224);
      p0 = (f32x16){b0[0], b0[1], b0[2], b0[3], b1[0], b1[1], b1[2], b1[3], b2[0], b2[1], b2[2], b2[3], b3[0], b3[1], b3[2], b3[3]};
      p1 = (f32x16){b4[0], b4[1], b4[2], b4[3], b5[0], b5[1], b5[2], b5[3], b6[0], b6[1], b6[2], b6[3], b7[0], b7[1], b7[2], b7[3]}; }
    const char* kb[4];
#pragma unroll
    for (int dd = 0; dd < 4; ++dd) kb[dd] = K_lds + KB * SHM_K + KSWZ(r32, (dd * 16 + hi * 8) * 2);
#pragma unroll
    for (int d0 = 0; d0 < 8; ++d0) { const char* a = kb[d0 & 3] + (d0 >> 2) * 128;
        bf16x8 b0 = *reinterpret_cast<const bf16x8*>(a);
        bf16x8 b1 = *reinterpret_cast<const bf16x8*>(a + 32 * 256);
        p0 = __builtin_amdgcn_mfma_f32_32x32x16_bf16(b0, qr[d0], p0, 0, 0, 0);
        p1 = __builtin_amdgcn_mfma_f32_32x32x16_bf16(b1, qr[d0], p1, 0, 0, 0); }
}
template <int VB, bool SK>
__device__ __forceinline__ void pv_tile(f32x16* o, int vb0, bf16x8 pa0, bf16x8 pa1, bf16x8 pa2, bf16x8 pa3, bool act) {
    if (SK && !act) return;
#define TRRD(dst, off) asm volatile("ds_read_b64_tr_b16 %0, %1 offset:%2" : "=&v"(dst) : "v"(vb0), "i"(off) : "memory")
#define PV_D0(d0) do { s16x4 l0, l1, l2, l3, h0, h1, h2, h3; constexpr int b_ = VB * SHM_V + v_rd_off(d0, 0, 0); \
        TRRD(l0, b_); TRRD(h0, b_ + 2048); TRRD(l1, b_ + 4096); TRRD(h1, b_ + 6144); TRRD(l2, b_ + 8192); TRRD(h2, b_ + 10240); TRRD(l3, b_ + 12288); TRRD(h3, b_ + 14336); \
        asm volatile("s_waitcnt lgkmcnt(0)" ::: "memory"); SBAR();   \
        o[d0] = __builtin_amdgcn_mfma_f32_32x32x16_bf16(pa0, (bf16x8){l0[0], l0[1], l0[2], l0[3], h0[0], h0[1], h0[2], h0[3]}, o[d0], 0, 0, 0);   \
        o[d0] = __builtin_amdgcn_mfma_f32_32x32x16_bf16(pa1, (bf16x8){l1[0], l1[1], l1[2], l1[3], h1[0], h1[1], h1[2], h1[3]}, o[d0], 0, 0, 0);   \
        o[d0] = __builtin_amdgcn_mfma_f32_32x32x16_bf16(pa2, (bf16x8){l2[0], l2[1], l2[2], l2[3], h2[0], h2[1], h2[2], h2[3]}, o[d0], 0, 0, 0);   \
        o[d0] = __builtin_amdgcn_mfma_f32_32x32x16_bf16(pa3, (bf16x8){l3[0], l3[1], l3[2], l3[3], h3[0], h3[1], h3[2], h3[3]}, o[d0], 0, 0, 0); } while (0)
    PV_D0(0); PV_D0(1); PV_D0(2); PV_D0(3);
#undef PV_D0
#undef TRRD
}

struct BlockRef { const GAS bf16_t* Q; const GAS bf16_t* K; const GAS bf16_t* V; GAS bf16_t* O; const GAS float* bt; int P0; int jl; };
struct Seam { bf16x8 qr[8]; bf16x8 st_v0, st_v1, st_k0, st_k1; };

#define ROW(p, k0, rr) ((p) + (size_t)((k0) + (rr)) * RS + sc)
#define VMW() asm volatile("s_waitcnt vmcnt(0)" ::: "memory")
#define VMWN(n) asm volatile("s_waitcnt vmcnt(%0)" :: "i"(n) : "memory")
#define SLOAD_H(Kp, Vp, k0) do { S.st_v0 = load8(ROW(Vp, k0, sr)); S.st_v1 = load8(ROW(Vp, k0, 32 + sr));              \
                         S.st_k0 = load8(ROW(Kp, k0, sr)); S.st_k1 = load8(ROW(Kp, k0, 32 + sr)); } while (0)
#define SWRITE_HK(bf) do { *(bf16x8*)(K_lds + (bf) * SHM_K + kws) = S.st_k0; *(bf16x8*)(K_lds + (bf) * SHM_K + kws + 32 * 256) = S.st_k1; } while (0)
#define SWRITE_HV(bf) do { *(bf16x8*)(V_lds + (bf) * SHM_V + vst0) = S.st_v0; *(bf16x8*)(V_lds + (bf) * SHM_V + vst1) = S.st_v1; } while (0)
#define SWRITE_H(bf) do { SWRITE_HV(bf); SWRITE_HK(bf); } while (0)

template <int MODE>
__device__ __forceinline__ void attn_prime(const BlockRef& cur, char* lds, Seam& S) {
    int tid = threadIdx.x; asm volatile("" : "+v"(tid));
    const int wid = __builtin_amdgcn_readfirstlane(tid >> 6), lane = tid & 63, r32 = lane & 31, hi = lane >> 5;
    const int sr = tid >> 4, sc = (tid & 15) * 8, kws = KSWZ(sr, sc * 2); char* K_lds = lds + 2 * SHM_V;
    const int kb0 = cur.jl * KVBLK;
#pragma unroll
    for (int d0 = 0; d0 < 8; ++d0) S.qr[d0] = load8(cur.Q + (size_t)(wid * QBLK + r32) * RS + d0 * 16 + hi * 8);
    SLOAD_H(cur.K, cur.V, kb0); VMW(); SWRITE_HK(0);
    __syncthreads();
}
template <int MODE>
__device__ __forceinline__ void attn_block(const BlockRef& cur, const BlockRef& nxt, char* lds, Seam& S, const bool newtab) {
    constexpr bool SK = (MODE == 1);
    int tid = threadIdx.x; asm volatile("" : "+v"(tid));
    const int wid = __builtin_amdgcn_readfirstlane(tid >> 6), lane = tid & 63, r32 = lane & 31, hi = lane >> 5;
    const int j_lo = cur.jl;
    const int j_hi = (cur.P0 >> 6) + 4;
    const int NT = j_hi - j_lo;
    const int kbn = nxt.jl * KVBLK;
    const int qlo = cur.P0 + wid * QBLK, qm = qlo + r32 - 4 * hi;
    const int cw = (cur.P0 >> 6) + (wid >> 1);
    char* V_lds = lds; char* K_lds = lds + 2 * SHM_V;
    float* ws = (float*)(lds + OFF_WS) + wid * 64; float* li_l = ws, * al_l = ws + 32;
    if (newtab) { float* tab = (float*)(lds + OFF_BIAS);
      if (MODE == 0) {
          _Pragma("clang loop vectorize(disable) unroll(disable)") for (int i = j_lo * KVBLK + tid; i < cur.P0 + QB; i += NW * 64) tab[i] = -cur.bt[i] * RSC; }
      else { _Pragma("clang loop vectorize(disable) unroll(disable)") for (int i = tid; i < 4 * CST; i += NW * 64) { const int a = i / CST, j = i - a * CST + a; int dist = 575 - j; dist = dist < -63 ? -63 : (dist > 256 ? 256 : dist);
                 tab[i] = cur.bt[dist + 63] * RSC; } }
      __syncthreads(); }
    int bl;
    if (MODE == 0) bl = OFF_BIAS + 16 * hi;
    else { const int tpos = cur.P0 + wid * QBLK + r32; const int a = (575 - tpos) & 3; bl = OFF_BIAS + a * (CST * 4) + 4 * (575 - tpos - a + 4 * hi); }
    asm volatile("" : "+v"(bl));
    float m_reg = -1e30f, l_reg = 0; f32x16 o[4] = {};
    if (wid >= 4) __builtin_amdgcn_s_setprio(1);
    const int sr = tid >> 4, sc = (tid & 15) * 8, vst0 = v_st(sr, sc), vst1 = v_st(32 + sr, sc), kws = KSWZ(sr, sc * 2);
    const int vb0 = (int)(uintptr_t)V_lds + v_rd_base(lane);
    const GAS bf16_t* Kh = cur.K; const GAS bf16_t* Vh = cur.V;
#define RESC(a) do { if (__any((a) < 1.f)) { if (hi == 0) al_l[r32] = (a); asm volatile("s_waitcnt lgkmcnt(0)" ::: "memory");              \
                     for (int d_ = 0; d_ < 4; ++d_) for (int r = 0; r < 16; ++r) o[d_][r] *= al_l[crow(r, hi)]; } } while (0)
#define KBASE(t) ((j_lo + (t)) * KVBLK)
#define BP(t) (lds + (bl + ((MODE == 0 || ACT(t)) ? KBASE(t) : cw * KVBLK) * 4))
#define ACT(t) (MODE == 0 ? true : ((j_lo + (t)) <= cw && (j_lo + (t)) >= cw - 8))
#define MASKT(P0_, P1_, t) do { if (MODE == 0) { const int kb_ = KBASE(t); if (kb_ + KVBLK - 1 > qlo) mask_tile(P0_, P1_, qm - kb_, 0x7fffffffu); } \
        else if (!ACT(t)) { const float NEG_ = -__builtin_inff(); _Pragma("unroll") for (int r_ = 0; r_ < 16; ++r_) { P0_[r_] = NEG_; P1_[r_] = NEG_; } } } while (0)
    constexpr int NQL = 8;
#define PSM(P0_, P1_, mn_, al_, t_) do { if (MODE == 1 && !ACT(t_)) { al_ = 1.f; } else partialSM(P0_, P1_, m_reg, mn_, al_); } while (0)
#define FSM(P0_, P1_, al_, t_) do { if (!(MODE == 1 && !ACT(t_))) finishSM(P0_, P1_, al_, l_reg, pa0, pa1, pa2, pa3); } while (0)
#define SEAM_K0() do { VMWN(NQL); SWRITE_HK(0); SBAR(); } while (0)
    f32x16 pA0, pA1, pB0, pB1; float mnA, mnB, alA, alB; bf16x8 pa0, pa1, pa2, pa3;
    SWRITE_HV(0); SBAR();
    if (NT > 1) { SLOAD_H(Kh, Vh, KBASE(1)); }
    SBAR(); qkt<0, SK>(pA0, pA1, K_lds, r32, hi, S.qr, ACT(0), BP(0));
    MASKT(pA0, pA1, 0); PSM(pA0, pA1, mnA, alA, 0);
    if (NT > 1) { VMW(); SWRITE_H(1); }
    __syncthreads();
#define HALF_STEP(PX0, PX1, mnX, alX, PY0, PY1, alY, t, KB, VB, SB) do {                                                      \
        SBAR(); qkt<KB, SK>(PX0, PX1, K_lds, r32, hi, S.qr, ACT(t), BP(t));                                      \
        FSM(PY0, PY1, alY, (t) - 1); SBAR();                                                                                  \
        if ((t) + 1 < NT) { SLOAD_H(Kh, Vh, KBASE((t) + 1)); SBAR(); }                                                        \
        pv_tile<VB, SK>(o, vb0, pa0, pa1, pa2, pa3, ACT((t) - 1)); MASKT(PX0, PX1, (t)); PSM(PX0, PX1, mnX, alX, (t));          \
        __syncthreads();                                                                                                      \
        if ((t) + 1 < NT) { VMW(); SWRITE_H(SB); }                                                                            \
        RESC(alX); __syncthreads(); } while (0)
    for (int t = 1; t + 1 < NT; t += 2) {
        HALF_STEP(pB0, pB1, mnB, alB, pA0, pA1, alA, t, 1, 0, 0);
        HALF_STEP(pA0, pA1, mnA, alA, pB0, pB1, alB, t + 1, 0, 1, 1);
    }
    const bool even = (NT & 1) == 0;
    if (even) { SBAR(); qkt<1, SK>(pB0, pB1, K_lds, r32, hi, S.qr, ACT(NT - 1), BP(NT - 1)); SBAR(); }
    SLOAD_H(nxt.K, nxt.V, kbn); SBAR();
#pragma unroll
    for (int d0 = 0; d0 < 8; ++d0) S.qr[d0] = load8(nxt.Q + (size_t)(wid * QBLK + r32) * RS + d0 * 16 + hi * 8);
    SBAR();
    FSM(pA0, pA1, alA, (even ? NT - 2 : NT - 1)); SBAR();
    pv_tile<0, SK>(o, vb0, pa0, pa1, pa2, pa3, ACT(even ? NT - 2 : NT - 1));
    if (even) { MASKT(pB0, pB1, NT - 1); PSM(pB0, pB1, mnB, alB, NT - 1); __syncthreads(); RESC(alB);
        FSM(pB0, pB1, alB, NT - 1); SBAR(); pv_tile<1, SK>(o, vb0, pa0, pa1, pa2, pa3, ACT(NT - 1)); }
    SBAR(); SEAM_K0();
    if (hi == 0) li_l[r32] = l_reg; asm volatile("s_waitcnt lgkmcnt(0)" ::: "memory");
    float rli[16];
#pragma unroll
    for (int r = 0; r < 16; ++r) rli[r] = __builtin_amdgcn_rcpf(li_l[crow(r, hi)]);
    GAS bf16_t* Ow = cur.O + (size_t)(wid * QBLK) * RS;
    char* ost = lds + OFF_OST + wid * OST_WAVE;
#pragma unroll
    for (int p = 0; p < 2; ++p) {
#pragma unroll
        for (int rr = 0; rr < 8; ++rr) { const int r = 8 * p + rr; const int lrow = crow(r, hi) - 16 * p;
#pragma unroll
            for (int d0 = 0; d0 < 4; ++d0) { const float v = o[d0][r] * rli[r]; const unsigned w = cvtpk(v, v);
                *(unsigned short*)(ost + lrow * 272 + (d0 * 32 + r32) * 2) = (unsigned short)w; } }
        asm volatile("s_waitcnt lgkmcnt(0)" ::: "memory");
#pragma unroll
        for (int k = 0; k < 4; ++k) { const int row = (lane >> 4) + 4 * k; const u32x4 w = *(const u32x4*)(ost + row * 272 + (lane & 15) * 16);
            *(GAS u32x4*)(Ow + (size_t)(16 * p + row) * RS + (lane & 15) * 8) = w; }
        asm volatile("s_waitcnt lgkmcnt(0)" ::: "memory");
    }
    if (wid >= 4) __builtin_amdgcn_s_setprio(0);
    __syncthreads();
#undef RESC
#undef KBASE
#undef BP
#undef ACT
#undef MASKT
#undef SEAM_K0
#undef PSM
#undef FSM
#undef HALF_STEP
}
#undef ROW
#undef VMW
#undef VMWN
#undef SLOAD_H
#undef SWRITE_HK
#undef SWRITE_HV
#undef SWRITE_H

template <int MODE>
__device__ __forceinline__ BlockRef block_ref(int n, int vcu, int G, const GAS bf16_t* Q, const GAS bf16_t* K, const GAS bf16_t* V, GAS bf16_t* O, const GAS float* bt, const GAS int* jtab) {
    int bh, qb;
    if (MODE == 0) {
        if (G == 2 * BATCH * NH) { bh = vcu >> 1; const int p = n >> 1; qb = (vcu & 1) ? ((n & 1) ? 13 - 4 * p : 14 - 4 * p) : ((n & 1) ? 12 - 4 * p : 15 - 4 * p); }
        else { const int L = vcu + n * G; bh = L >> 4; qb = 15 - (L & 15); }
    } else {
        if (G == 2 * BATCH * NH) { bh = vcu >> 1; qb = (vcu & 1) ? (n == 0 ? 1 : n + 8) : (n == 0 ? 0 : n + 1); }
        else { const int L = vcu + n * G; bh = L >> 4; qb = L & 15; }
    }
    const int b = bh >> 4, h = bh & 15;
    BlockRef r; const size_t row0 = (size_t)b * SEQ;
    r.Q = Q + (row0 + (size_t)qb * QB) * RS + h * D; r.O = O + (row0 + (size_t)qb * QB) * RS + h * D;
    r.K = K + row0 * RS + h * D; r.V = V + row0 * RS + h * D; r.P0 = qb * QB;
    r.bt = MODE == 0 ? bt + (size_t)bh * SEQ : bt + h * NREL;
    if (MODE == 0) r.jl = jtab[bh * 16 + qb]; else { const int j = (r.P0 >> 6) - 8; r.jl = j > 0 ? j : 0; }
    return r;
}
template <int MODE>
__device__ __forceinline__ void attn_phase(char* lds, int vcu, int G, const GAS bf16_t* Q, const GAS bf16_t* K, const GAS bf16_t* V, GAS bf16_t* O, const GAS float* bt, const GAS int* jtab) {
    asm volatile("" : "+s"(Q), "+s"(K), "+s"(V), "+s"(O), "+s"(bt), "+s"(vcu), "+s"(jtab), "+s"(G));
    const int total = BATCH * NH * 16;
    int nblk = 0; for (int L = vcu; L < total; L += G) ++nblk;
    if (nblk == 0) return;
    BlockRef cur = block_ref<MODE>(0, vcu, G, Q, K, V, O, bt, jtab);
    Seam S;
    attn_prime<MODE>(cur, lds, S);
    const GAS float* prev_bt = nullptr;
    for (int n = 0; n < nblk; ++n) {
        const bool last = (n + 1 == nblk);
        const BlockRef nxt = last ? cur : block_ref<MODE>(n + 1, vcu, G, Q, K, V, O, bt, jtab);
        attn_block<MODE>(cur, nxt, lds, S, cur.bt != prev_bt);
        prev_bt = cur.bt; cur = nxt;
    }
}
__device__ __forceinline__ BlockRef ticket_ref(int ticket, const GAS bf16_t* Q, const GAS bf16_t* K, const GAS bf16_t* V, GAS bf16_t* O, const GAS float* bt, const GAS int* jtab) {
    const int q = ticket >> 8, i = ticket & 255, qb = 15 - (i >> 4), bh = q * 16 + (i & 15);
    const int b = bh >> 4, h = bh & 15;
    BlockRef r; const size_t row0 = (size_t)b * SEQ;
    r.Q = Q + (row0 + (size_t)qb * QB) * RS + h * D; r.O = O + (row0 + (size_t)qb * QB) * RS + h * D;
    r.K = K + row0 * RS + h * D; r.V = V + row0 * RS + h * D; r.P0 = qb * QB;
    r.bt = bt + (size_t)bh * SEQ; r.jl = jtab[bh * 16 + qb];
    return r;
}
__device__ __forceinline__ void attn_phase_dyn(char* lds, GAS unsigned* qc  , const GAS bf16_t* Q, const GAS bf16_t* K, const GAS bf16_t* V, GAS bf16_t* O, const GAS float* bt, const GAS int* jtab) {
    asm volatile("" : "+s"(Q), "+s"(K), "+s"(V), "+s"(O), "+s"(bt), "+s"(jtab), "+s"(qc));
    volatile LAS int* tk = (volatile LAS int*)(LAS char*)(lds + OFF_BIAS + 16384 + 64);
    const unsigned xq = (unsigned)__builtin_amdgcn_s_getreg((3 << 11) | 20) & 7u;
    int slot = 0; if (threadIdx.x == 0) tk[2] = 0;
#define TK_PULL(out) do { if (threadIdx.x == 0) { unsigned t_ = 256u, kq = (unsigned)tk[2]; for (;;) { t_ = __hip_atomic_fetch_add(qc + 64 * ((xq + kq) & 7u), 1u, __ATOMIC_RELAXED, __HIP_MEMORY_SCOPE_AGENT); if (t_ < 256u || kq >= 7u) break; ++kq; } \
            tk[2] = (int)kq; tk[slot] = (t_ < 256u) ? (int)((((xq + kq) & 7u) << 8) | t_) : -1; } \
        __syncthreads(); out = __builtin_amdgcn_readfirstlane(tk[slot]); slot ^= 1; } while (0)
    int tc, tn;
    TK_PULL(tc); if (tc < 0) return;
    TK_PULL(tn);
    BlockRef cur = ticket_ref(tc, Q, K, V, O, bt, jtab);
    Seam S;
    attn_prime<0>(cur, lds, S);
    for (;;) {
        const bool last = tn < 0;
        const BlockRef nxt = last ? cur : ticket_ref(tn, Q, K, V, O, bt, jtab);
        attn_block<0>(cur, nxt, lds, S, true);
        if (last) break;
        cur = nxt; TK_PULL(tn);
    }
#undef TK_PULL
}
}


#define XB_TMO      128
#define XB_XCNT(j)  (256  + 64 * (j))
#define XB_XSUB(j)  (1280 + 64 * (j))
#define XB_XGEN(j)  (2304 + 64 * (j))
#define XB_TOP      3328
#define XB_TOPGEN   3392
#define XCD_BAR_WORDS 3456
#define XB_SPIN_CAP (1u << 18)
__device__ __forceinline__ unsigned xb_ld(unsigned* p)              { return __hip_atomic_load(p, __ATOMIC_RELAXED, __HIP_MEMORY_SCOPE_AGENT); }
__device__ __forceinline__ unsigned xb_add(unsigned* p, unsigned v) { return __hip_atomic_fetch_add(p, v, __ATOMIC_RELAXED, __HIP_MEMORY_SCOPE_AGENT); }
__device__ __forceinline__ unsigned xb_xcc_id() { return (unsigned)__builtin_amdgcn_s_getreg((3 << 11) | 20) & 0xFu; }
#define XB_SPIN(cond, bar) do { unsigned _sp = 0; while (cond) { __builtin_amdgcn_s_sleep(1); \
    if ((++_sp & 255u) == 0u) { if (xb_ld(&(bar)[XB_TMO])) break; if (_sp > XB_SPIN_CAP) { atomicAdd(&(bar)[XB_TMO], 1u); break; } } } } while (0)
struct XcdBarrier { unsigned* bar; unsigned x; volatile LAS unsigned* st; };
__device__ __forceinline__ XcdBarrier xcd_barrier_post(unsigned* bar, volatile LAS unsigned* st) {
    XcdBarrier b; b.bar = bar; b.x = xb_xcc_id(); b.st = st;
    if (threadIdx.x == 0) (void)xb_add(&bar[XB_XCNT(b.x)], 1u);
    return b;
}
__device__ __forceinline__ void xcd_barrier_complete(unsigned* bar, unsigned x, unsigned& nloc, unsigned& nx) {
    const unsigned G = gridDim.x * gridDim.y * gridDim.z;
    unsigned sum, cnt, mine, sp = 0u;
    for (;;) {
        sum = 0u; cnt = 0u; mine = 0u;
#pragma unroll
        for (unsigned j = 0; j < 16; ++j) { const unsigned c = xb_ld(&bar[XB_XCNT(j)]); sum += c; cnt += (c > 0u) ? 1u : 0u; mine = (j == x) ? c : mine; }
        if (sum == G) break;
        __builtin_amdgcn_s_sleep(1);
        if ((++sp & 255u) == 0u) { if (xb_ld(&bar[XB_TMO])) break; if (sp > XB_SPIN_CAP) { atomicAdd(&bar[XB_TMO], 1u); break; } }
    }
    nloc = mine > 0u ? mine : 1u; nx = cnt > 0u ? cnt : 1u;
}
__device__ __forceinline__ void xcd_barrier(const XcdBarrier& b) {
    asm volatile("s_waitcnt vmcnt(0)" ::: "memory");
    __syncthreads();
    if (threadIdx.x == 0) {
        unsigned* bar = b.bar;
        __builtin_amdgcn_s_waitcnt(0);
        unsigned nloc = b.st[0], nx = b.st[1];
        if (nloc == 0u) { xcd_barrier_complete(bar, b.x, nloc, nx); b.st[0] = nloc; b.st[1] = nx; }
        const unsigned old = xb_add(&bar[XB_XSUB(b.x)], 1u);
        const unsigned gen = old / nloc;
        if (old + 1u == (gen + 1u) * nloc) {
            __builtin_amdgcn_fence(__ATOMIC_RELEASE, "agent");
            asm volatile("s_waitcnt vmcnt(0)" ::: "memory");
            const unsigned og = xb_add(&bar[XB_TOP], 1u);
            const unsigned tg = og / nx;
            if (og + 1u == (tg + 1u) * nx) xb_add(&bar[XB_TOPGEN], 1u);
            else XB_SPIN(xb_ld(&bar[XB_TOPGEN]) == tg, bar);
            __builtin_amdgcn_fence(__ATOMIC_ACQUIRE, "agent");
            xb_add(&bar[XB_XGEN(b.x)], 1u);
            asm volatile("s_waitcnt vmcnt(0)" ::: "memory");
        } else {
            XB_SPIN(xb_ld(&bar[XB_XGEN(b.x)]) == gen, bar);
            __builtin_amdgcn_fence(__ATOMIC_ACQUIRE, "agent");
            asm volatile("s_waitcnt vmcnt(0)" ::: "memory");
        }
    }
    __syncthreads();
}

__device__ __forceinline__ float wave_sum(float v) {
#pragma unroll
    for (int o = 1; o < 64; o <<= 1) v += __shfl_xor(v, o);
    return v;
}
__device__ __forceinline__ unsigned f2bf(float f) { unsigned u = __builtin_bit_cast(unsigned, f); return (u + 0x7fffu + ((u >> 16) & 1u)) >> 16; }
__device__ __forceinline__ unsigned pk2(float lo, float hi) { return f2bf(lo) | (f2bf(hi) << 16); }
__device__ __forceinline__ void transpose_item(const GAS float* W, int K, int N, int ldn, const GAS float* gk, GAS bf16_t* WT, int row_off, LAS float* scr, int item, int nblk, int lane) {
    const int kb = item / nblk, nb = item - kb * nblk, k0 = 64 * kb, n0 = 32 * nb;
    const int n = n0 + (lane & 31);
    float wv[32];
#pragma unroll
    for (int i = 0; i < 32; ++i) { const int kk = 2 * i + (lane >> 5); wv[i] = 0.f; if (n < N) wv[i] = __builtin_nontemporal_load(W + (size_t)(k0 + kk) * ldn + n); }
#pragma unroll
    for (int i = 0; i < 32; ++i) { const int kk = 2 * i + (lane >> 5); float v = wv[i]; if (gk) v *= gk[k0 + kk]; scr[kk * 33 + (lane & 31)] = v; }
    LDS_WAIT(); asm volatile("" ::: "memory");
    const int c = lane & 7;
#pragma unroll
    for (int j = 0; j < 4; ++j) { const int nn = (lane >> 3) + 8 * j; const LAS float* s = scr + (8 * c) * 33 + nn;
        u32x4 o; o.x = pk2(s[0 * 33], s[1 * 33]); o.y = pk2(s[2 * 33], s[3 * 33]); o.z = pk2(s[4 * 33], s[5 * 33]); o.w = pk2(s[6 * 33], s[7 * 33]);
        *(GAS u32x4*)(WT + (size_t)(row_off + n0 + nn) * K + k0 + 8 * c) = o; }
    LDS_WAIT(); asm volatile("" ::: "memory");
}
__device__ __forceinline__ void seed_row(const GAS float* xrow, GAS bf16_t* orow, GAS float* ssq8, int lane) {
    asm volatile("" : "+v"(lane));
    const GAS f32x4* xr = (const GAS f32x4*)xrow + lane;
    f32x4 v[8]; float s = 0.f;
#pragma unroll
    for (int j = 0; j < 8; ++j) { v[j] = xr[64 * j]; s += (v[j][0] * v[j][0] + v[j][1] * v[j][1]) + (v[j][2] * v[j][2] + v[j][3] * v[j][3]); }
    GAS u32x2* o8 = (GAS u32x2*)orow + lane;
#pragma unroll
    for (int j = 0; j < 8; ++j) { u32x2 w; w.x = pk2(v[j][0], v[j][1]); w.y = pk2(v[j][2], v[j][3]); o8[64 * j] = w; }
    s = wave_sum(s);
    if (lane < 8) ssq8[lane] = lane == 0 ? s : 0.f;
}

struct Args { const float* in[18]; float* out; unsigned char* ws; };
enum { I_X = 0, I_ANG, I_AWIN, I_ABF, I_AQG, I_AKG, I_AWOUT, I_MNG, I_W1, I_W2, I_KVNG, I_KVW, I_KVKG, I_BNG, I_BWQ, I_BQG, I_BREL, I_BWOUT };

__global__ void __launch_bounds__(512, 2) fwd_megakernel(Args a) {
    extern __shared__ __attribute__((aligned(16))) unsigned char lds[];
    cg::grid_group grid = cg::this_grid();
    LAS unsigned char* L = (LAS unsigned char*)lds;
    const int wave = __builtin_amdgcn_readfirstlane(threadIdx.x >> 6);
    const int G = gridDim.x, bx = blockIdx.x;
    const int vcu = (G % 8 == 0) ? (bx % 8) * (G / 8) + bx / 8 : bx;
    GAS unsigned char* ws = (GAS unsigned char*)a.ws;
    GAS float* LF = (GAS float*)(ws + WS_LF); GAS float* GT = (GAS float*)(ws + WS_GT); GAS int* JT = (GAS int*)(ws + WS_GT + 8192);
    GAS bf16_t* WIN = (GAS bf16_t*)(ws + WS_WIN); GAS bf16_t* WOA = (GAS bf16_t*)(ws + WS_WOA); GAS bf16_t* W1T = (GAS bf16_t*)(ws + WS_W1); GAS bf16_t* W2T = (GAS bf16_t*)(ws + WS_W2);
    GAS bf16_t* WKVQ = (GAS bf16_t*)(ws + WS_WKVQ); GAS bf16_t* WOB = (GAS bf16_t*)(ws + WS_WOB);
    GAS bf16_t* U2 = (GAS bf16_t*)(ws + WS_U2); GAS float* SSQ = (GAS float*)(ws + WS_SSQ);
    GAS bf16_t* U = (GAS bf16_t*)(ws + WS_U); GAS bf16_t* QKV = (GAS bf16_t*)(ws + WS_QKV); GAS bf16_t* HID = QKV;
    GAS float* out = (GAS float*)a.out;
#define IN(i) ((const GAS float*)a.in[i])
    const int gw = vcu * 8 + wave, NGW = G * 8;
    if (threadIdx.x < 4) ((LAS unsigned*)(L + BARW_OFF))[threadIdx.x] = 0u;
    __syncthreads();
    if (bx == 0) for (int i = threadIdx.x; i < 4096; i += 512) ((GAS unsigned*)a.ws)[i] = 0u;
#define GRID_BAR() xcd_barrier(xbar)

    constexpr int I0 = 32 * 200, I1 = 32 * 64, I2 = 32 * 256, I3 = 128 * 64, I4 = 32 * 128, I5 = 32 * 64, I6 = 32 * 64;
    constexpr int NP0 = I0 + I1 + 2 * I2 + I3 + I4 + I5, NDEF = I3 + I6;
    for (int rep_ = 0; rep_ < (PROBE_REPEAT == 1 ? 2 : 1); ++rep_) {
        int tid = threadIdx.x; asm volatile("" : "+v"(tid)); const int lane = tid & 63;
        LAS float* scr = (LAS float*)(L + wave * 16384);
        for (int it = gw; it < NP0; it += NGW) {
            int r = it;
            if (r < I0) { transpose_item(IN(I_AWIN), DM, 3 * DM + NH, 3 * DM + NH, IN(I_ANG), WIN, 0, scr, r, 200, lane); continue; } r -= I0;
            if (r < I1) { transpose_item(IN(I_AWOUT), DM, DM, DM, nullptr, WOA, 0, scr, r, 64, lane); continue; } r -= I1;
            if (r < I2) { transpose_item(IN(I_W1), DM, FF, FF, IN(I_MNG), W1T, 0, scr, r, 256, lane); continue; } r -= I2;
            if (r < I2) { transpose_item(IN(I_W1) + (size_t)DM * FF, DM, FF, FF, IN(I_MNG) + DM, W1T + (size_t)FF * DM, 0, scr, r, 256, lane); continue; } r -= I2;
            if (r < I3) { transpose_item(IN(I_W2), FF, DM, DM, nullptr, W2T, 0, scr, r, 64, lane); continue; } r -= I3;
            if (r < I4) { transpose_item(IN(I_KVW), DM, 2 * DM, 2 * DM, IN(I_KVNG), WKVQ, 0, scr, r, 128, lane); continue; } r -= I4;
            transpose_item(IN(I_BWQ), DM, DM, DM, IN(I_BNG), WKVQ, 2 * DM, scr, r, 64, lane);
        }
        for (int m = gw; m < M; m += NGW) seed_row(IN(I_X) + (size_t)m * DM, U2 + (size_t)m * DM, SSQ + (size_t)24 * M + (size_t)m * 8, lane);
        if (bx == 0 && tid < HD) { GT[tid] = IN(I_AQG)[tid]; GT[HD + tid] = IN(I_AKG)[tid]; GT[2 * HD + tid] = 1.f;
            GT[3 * HD + tid] = IN(I_KVKG)[tid]; GT[4 * HD + tid] = 1.f; GT[5 * HD + tid] = IN(I_BQG)[tid]; }
    }
    grid.sync();
    const XcdBarrier xbar = xcd_barrier_post((unsigned*)a.ws, (volatile LAS unsigned*)(L + BARW_OFF));

    {
        pg8::Gemm g{U2, WIN, M, NIN_A, DM}; pg8::StaticOrder S; S.init(M, NIN_A, G, bx);
        pg8::EpiQKV E{QKV, GT, 3, LF, IN(I_ABF), SSQ + (size_t)24 * M, (LAS float*)(L + XCH_OFF)};
#ifndef NO_EPIQKV_1
        pg8::gemm_phase<pg8::EpiQKV>(L, g, S, E);
#endif
    }
    {
        const int rr = ((M / 256) * (NIN_A / 256)) % G;
        int didx = -1, dstride = 1;
        if (rr == 0) { didx = bx * 8 + wave; dstride = G * 8; } else if (bx >= rr) { didx = (bx - rr) * 8 + wave; dstride = (G - rr) * 8; }
        if (didx >= 0) {
            int tid = threadIdx.x; asm volatile("" : "+v"(tid)); const int lane = tid & 63;
            LAS float* scr = (LAS float*)(L + wave * 16384);
            for (int it = didx; it < NDEF; it += dstride) {
                if (it < I3) transpose_item(IN(I_W2) + (size_t)FF * DM, FF, DM, DM, nullptr, W2T + (size_t)DM * FF, 0, scr, it, 64, lane);
                else transpose_item(IN(I_BWOUT), DM, DM, DM, nullptr, WOB, 0, scr, it - I3, 64, lane);
            }
        }
    }
    GRID_BAR();

    if (bx < BATCH * NH) {
        int tid = threadIdx.x; asm volatile("" : "+v"(tid)); const int lane = tid & 63;
        GAS float* p = LF + (size_t)bx * SEQ + tid * 8;
        f32x4 v0 = *(const GAS f32x4*)p, v1 = *(const GAS f32x4*)(p + 4);
        v0[1] += v0[0]; v0[2] += v0[1]; v0[3] += v0[2]; v1[0] += v0[3]; v1[1] += v1[0]; v1[2] += v1[1]; v1[3] += v1[2];
        const float tot = v1[3]; float x = tot;
#pragma unroll
        for (int o = 1; o < 64; o <<= 1) { const float t = __shfl_up(x, o); if (lane >= o) x += t; }
        LAS float* wt = (LAS float*)L;
        LAS float* cs = (LAS float*)(L + 256);
        if (lane == 63) wt[wave] = x;
        float gq = 0.f, gk = 0.f;
        if (tid < 64) { gq = fmaxf(fabsf(GT[tid]), fabsf(GT[tid + 64])); gk = fmaxf(fabsf(GT[HD + tid]), fabsf(GT[HD + tid + 64]));
#pragma unroll
            for (int o = 1; o < 64; o <<= 1) { gq = fmaxf(gq, __shfl_xor(gq, o)); gk = fmaxf(gk, __shfl_xor(gk, o)); }
            if (tid == 0) wt[8] = 2.f * 1.02f * RSC * gq * gk + 26.f; }
        __syncthreads();
        float off = x - tot;
        for (int w = 0; w < wave; ++w) off += wt[w];
        v0 = v0 + off; v1 = v1 + off;
        *(GAS f32x4*)p = v0; *(GAS f32x4*)(p + 4) = v1;
        *(LAS f32x4*)(cs + tid * 8) = v0; *(LAS f32x4*)(cs + tid * 8 + 4) = v1;
        __syncthreads();
        if (tid < 16) { const int P0 = tid * 256; const float cq = cs[P0], T = wt[8]; int t = 0;
            while (t < (P0 >> 6) && cq - cs[64 * t + 63] < -T) ++t;
            JT[bx * 16 + tid] = t; }
    }
    GRID_BAR();

#ifndef NO_ATT0
    att::attn_phase_dyn((char*)lds, (GAS unsigned*)a.ws + 3520, QKV, QKV + SEG, QKV + 2 * SEG, U, LF, JT);
#endif
#if PROBE_REPEAT == 3
    __syncthreads(); att::attn_phase<0>((char*)lds, vcu, G, QKV, QKV + SEG, QKV + 2 * SEG, U, LF, JT);
#endif
    GRID_BAR();

    {
        pg8::Gemm g{U, WOA, M, DM, DM}; pg8::StaticOrder S; S.init(M, DM, G, bx);
        pg8::EpiResid E{nullptr, U2, nullptr, U2, SSQ, (LAS float*)(L + XCH_OFF)};
#ifndef NO_EPIRESID_1
        pg8::gemm_phase<pg8::EpiResid>(L, g, S, E);
#endif
    }
    GRID_BAR();

#define MLP_BLOCK(layer, SSQ_IN, OUTF, HB_OUT, SSQ_OUT) do { \
        { pg8::Gemm g{U2, W1T + (size_t)(layer) * FF * DM, M, FF, DM}; pg8::StaticOrder S; S.init(M, FF, G, bx); \
          pg8::EpiRelu2 E{HID, SSQ_IN}; \
          pg8::gemm_phase<pg8::EpiRelu2>(L, g, S, E); \
          if (PROBE_REPEAT == 6 && (layer) == 0) { __syncthreads(); pg8::gemm_phase<pg8::EpiRelu2>(L, g, S, E); } } \
        GRID_BAR(); \
        { pg8::Gemm g{HID, W2T + (size_t)(layer) * DM * FF, M, DM, FF}; pg8::StaticOrder S; S.init(M, DM, G, bx); \
          pg8::EpiResid E{nullptr, U2, OUTF, HB_OUT, SSQ_OUT, (LAS float*)(L + XCH_OFF)}; \
          pg8::gemm_phase<pg8::EpiResid>(L, g, S, E); } } while (0)
    MLP_BLOCK(0, SSQ, (GAS float*)nullptr, U2, SSQ + (size_t)8 * M);
    GRID_BAR();
    {
        pg8::Gemm g{U2, WKVQ, M, NIN_B, DM}; pg8::StaticOrder S; S.init(M, NIN_B, G, bx);
        pg8::EpiQKV E{QKV, GT + 3 * HD, 5, nullptr, nullptr, SSQ + (size_t)8 * M, (LAS float*)(L + XCH_OFF)};
        pg8::gemm_phase<pg8::EpiQKV>(L, g, S, E);
    }
    GRID_BAR();
    att::attn_phase<1>((char*)lds, vcu, G, QKV + 2 * SEG, QKV, QKV + SEG, U, IN(I_BREL), JT);
#if PROBE_REPEAT == 10
    __syncthreads(); att::attn_phase<1>((char*)lds, vcu, G, QKV + 2 * SEG, QKV, QKV + SEG, U, IN(I_BREL), JT);
#endif
    GRID_BAR();
    {
        pg8::Gemm g{U, WOB, M, DM, DM}; pg8::StaticOrder S; S.init(M, DM, G, bx);
        pg8::EpiResid E{nullptr, U2, nullptr, U2, SSQ + (size_t)16 * M, (LAS float*)(L + XCH_OFF)};
        pg8::gemm_phase<pg8::EpiResid>(L, g, S, E);
    }
    GRID_BAR();
    MLP_BLOCK(1, SSQ + (size_t)16 * M, out, (GAS bf16_t*)nullptr, (GAS float*)nullptr);
#undef MLP_BLOCK
}

extern "C" void kernel_launch(void* const* d_in, const int* in_sizes, int n_in, void* d_out, int out_size, void* d_ws, size_t ws_size, hipStream_t stream) {
    static int grid = 0;
    if (grid == 0) {
        if (n_in != 18 || in_sizes[0] != M * DM || out_size != M * DM || ws_size < WS_END) {
            fprintf(stderr, "kernel_launch: shape mismatch (n_in %d in0 %d out %d ws %zu)\n", n_in, n_in > 0 ? in_sizes[0] : -1, out_size, ws_size); grid = -1; return; }
        int dev = 0, cus = 0, per_cu = 0;
        (void)hipGetDevice(&dev);
        if (hipDeviceGetAttribute(&cus, hipDeviceAttributeMultiprocessorCount, dev) != hipSuccess || cus <= 0) cus = 256;
        if (hipFuncSetAttribute((const void*)fwd_megakernel, hipFuncAttributeMaxDynamicSharedMemorySize, LDS_BYTES) != hipSuccess) { fprintf(stderr, "kernel_launch: hipFuncSetAttribute failed\n"); grid = -1; return; }
        if (hipOccupancyMaxActiveBlocksPerMultiprocessor(&per_cu, (const void*)fwd_megakernel, 512, LDS_BYTES) != hipSuccess || per_cu < 1) { fprintf(stderr, "kernel_launch: occupancy query says %d\n", per_cu); per_cu = 1; }
        (void)hipGetLastError();
        grid = cus * per_cu;
    }
    if (grid < 0) return;
    Args a{};
    for (int i = 0; i < 18; ++i) a.in[i] = (const float*)d_in[i];
    a.out = (float*)d_out; a.ws = (unsigned char*)d_ws;
    void* args[] = {&a};
    hipError_t e = hipLaunchCooperativeKernel((const void*)fwd_megakernel, dim3(grid), dim3(512), args, LDS_BYTES, stream);
    if (e != hipSuccess) fprintf(stderr, "kernel_launch: cooperative launch failed: %s (grid %d)\n", hipGetErrorString(e), grid);
}
```

```cpp
#include <hip/hip_runtime.h>
#include <hip/hip_cooperative_groups.h>
#include <cstdio>
#include <cstdint>
namespace cg = cooperative_groups;

#ifndef STAGGER_TICKS
#define STAGGER_TICKS 0
#endif
#ifndef PROBE_REPEAT
#define PROBE_REPEAT 0
#endif
#define LAS __attribute__((address_space(3)))
#define GAS __attribute__((address_space(1)))
typedef unsigned short bf16_t;
typedef short bf16x8 __attribute__((ext_vector_type(8)));
typedef short s16x4 __attribute__((ext_vector_type(4)));
typedef float f32x4 __attribute__((ext_vector_type(4)));
typedef float f32x16 __attribute__((ext_vector_type(16)));
typedef unsigned u32x4 __attribute__((ext_vector_type(4)));
typedef unsigned u32x2 __attribute__((ext_vector_type(2)));

constexpr int BATCH = 8, SEQ = 4096, DM = 2048, NH = 16, HD = 128, FF = 8192, NREL = 320;
constexpr int M = BATCH * SEQ;
constexpr int NIN_A = 3 * DM + 256;
constexpr int NIN_B = 3 * DM;
constexpr float EPS = 1e-6f;
constexpr float SCALE = 0.08838834764831845f;
constexpr float RSC = 11.313708498984761f;

constexpr size_t MiB = 1u << 20;
constexpr size_t WS_GT = 512 * 1024;
constexpr size_t WS_LF = 1 * MiB;
constexpr size_t WS_WIN = 4 * MiB;
constexpr size_t WS_WOA = 29 * MiB;
constexpr size_t WS_W1 = 37 * MiB;
constexpr size_t WS_W2 = 101 * MiB;
constexpr size_t WS_WKVQ = 165 * MiB;
constexpr size_t WS_WOB = 189 * MiB;
constexpr size_t WS_U = 200 * MiB;
constexpr size_t WS_QKV = 328 * MiB;
constexpr size_t SEG = (size_t)M * DM;
constexpr size_t WS_U2 = 840 * MiB;
constexpr size_t WS_SSQ = 968 * MiB;
constexpr size_t WS_END = 972 * MiB;

constexpr int RING_BYTES = 131072;
constexpr int XCH_OFF = RING_BYTES;
constexpr int BARW_OFF = XCH_OFF + 8192;
constexpr int LDS_BYTES = 147456;

__device__ __forceinline__ unsigned cvt_pk_bf16(float lo, float hi) { unsigned r; asm volatile("v_cvt_pk_bf16_f32 %0, %1, %2" : "=v"(r) : "v"(lo), "v"(hi)); return r; }
#define LDS_WAIT() asm volatile("s_waitcnt lgkmcnt(0)" ::: "memory")

namespace pg8 {
constexpr int BM = 256, BK = 64, HALF = 128, HTB = HALF * BK * 2, NXCD = 8, WGM = 8;
__host__ __device__ __forceinline__ int lds_byte(int r, int c) { const int st = (r >> 4) * 2 + (c >> 5), rr = r & 15, cc = c & 31, ob = rr * 64 + cc * 2; return st * 1024 + (ob ^ (((ob >> 9) & 1) << 5)); }
__host__ __device__ __forceinline__ void stage_rc(int b, int& R, int& C) { const int st = b / 1024, sb = b % 1024, swz = sb ^ (((sb >> 9) & 1) << 5); R = (st >> 1) * 16 + swz / 64; C = (st & 1) * 32 + (swz % 64) / 2; }
__host__ __device__ __forceinline__ int perm32(int rho) { const int n = rho >> 4, i = rho & 15; return 8 * (i >> 2) + 4 * n + (i & 3); }

struct Unit { int pm, pn; };
struct Gemm { const GAS bf16_t* A; const GAS bf16_t* Bt; int M, N, K; };

struct StaticOrder {
    int nM, nN, nwg, G, c;
    __device__ void init(int M_, int N_, int G_, int c_) { nM = M_ / BM; nN = N_ / BM; nwg = nM * nN; G = G_; c = c_; }
    __device__ bool next(int i, Unit& u) const {
        const long L = (long)i * G + c; if (L >= nwg) return false;
        int wgid = (int)L; { const int q = nwg / NXCD, r = nwg % NXCD, xcd = wgid % NXCD, off = wgid / NXCD; wgid = (xcd < r ? xcd * (q + 1) : r * (q + 1) + (xcd - r) * q) + off; }
        const int nig = WGM * nN, gid = wgid / nig, fm = gid * WGM, gsz = (nM - fm) < WGM ? (nM - fm) : WGM;
        u.pm = fm + ((wgid % nig) % gsz); u.pn = (wgid % nig) / gsz; return true;
    }
};


struct EpiQKV {
    static constexpr bool PERM = true;
    GAS bf16_t* O;
    const GAS float* gt; int normmask;
    GAS float* logf; const GAS float* bfg;
    const GAS float* ssq;
    LAS float* xch;
    __device__ __forceinline__ void operator()(const f32x4 (&acc)[2][2][4][2], const Unit& u, int wr, int wc, int fr, int fq) const {
        const int t = u.pn >> 3;
        const int row0 = u.pm * BM + wr * 64 + fr;
        if (t == 3) {
            if (wc == 0 && fq < 2) {
#pragma unroll
                for (int ai = 0; ai < 2; ++ai)
#pragma unroll
                    for (int m = 0; m < 4; ++m) { const int row = row0 + ai * HALF + m * 16; const int b = row >> 12, s = row & 4095;
                        float rw = 1.f;
                        if (ssq) { const GAS f32x4* pp = (const GAS f32x4*)(ssq + (size_t)row * 8); const f32x4 p = pp[0], q = pp[1];
                            rw = rsqrtf((((p[0] + p[1]) + (p[2] + p[3])) + ((q[0] + q[1]) + (q[2] + q[3]))) * (1.f / DM) + EPS); }
#pragma unroll
                        for (int n = 0; n < 2; ++n)
#pragma unroll
                            for (int j = 0; j < 4; ++j) { const int c = 8 * fq + 4 * n + j; const float z = acc[ai][0][m][n][j] * rw + bfg[c];
                                const float lf = fminf(z, 0.f) - __logf(1.f + __expf(-fabsf(z)));
                                logf[((size_t)(b * NH + c)) * SEQ + s] = lf; } }
            }
            return;
        }
        const GAS float* gp = gt + t * HD; const bool g = (normmask >> t) & 1;
        GAS bf16_t* base = O + (size_t)t * SEG;
        const int colt = (u.pn & 7) * BM + wc * 32 + 8 * fq;
        f32x4 gv0 = (f32x4){1.f, 1.f, 1.f, 1.f}, gv1 = gv0;
        float rw2a[2][4];
        if (ssq) {
#pragma unroll
            for (int ai = 0; ai < 2; ++ai)
#pragma unroll
                for (int m = 0; m < 4; ++m) { const GAS float* pp = ssq + (size_t)(row0 + ai * HALF + m * 16) * 8 + 2 * fq; rw2a[ai][m] = pp[0] + pp[1]; }
#pragma unroll
            for (int ai = 0; ai < 2; ++ai)
#pragma unroll
                for (int m = 0; m < 4; ++m) { float st = rw2a[ai][m]; st += __shfl_xor(st, 16); st += __shfl_xor(st, 32); rw2a[ai][m] = 1.f / (st * (1.f / DM) + EPS); } }
        if (g) {
#pragma unroll
            for (int ai = 0; ai < 2; ++ai)
#pragma unroll
                for (int m = 0; m < 4; ++m)
#pragma unroll
                    for (int bj = 0; bj < 2; ++bj) { const f32x4 a = acc[ai][bj][m][0], b = acc[ai][bj][m][1];
                        float s = (a[0] * a[0] + a[1] * a[1]) + (a[2] * a[2] + a[3] * a[3]) + (b[0] * b[0] + b[1] * b[1]) + (b[2] * b[2] + b[3] * b[3]);
                        s += __shfl_xor(s, 16); s += __shfl_xor(s, 32);
                        if (fq == 0) xch[((ai * HALF + wr * 64 + m * 16 + fr) * 2 + bj) * 4 + wc] = s; }
            LDS_WAIT(); __builtin_amdgcn_s_barrier(); asm volatile("" ::: "memory");
            int go = wc * 32 + 8 * fq; asm volatile("" : "+v"(go));
            gv0 = *(const GAS f32x4*)(gp + go); gv1 = *(const GAS f32x4*)(gp + go + 4);
        }
#pragma unroll
        for (int ai = 0; ai < 2; ++ai)
#pragma unroll
            for (int m = 0; m < 4; ++m) { GAS bf16_t* rowp = base + (size_t)(row0 + ai * HALF + m * 16) * DM + colt;
                float r0 = 1.f, r1 = 1.f, rw = 1.f, rw2 = 1.f;
                if (ssq) { rw2 = rw2a[ai][m]; rw = sqrtf(rw2); }
                if (g) { const LAS f32x4* pp = (const LAS f32x4*)(xch + ((ai * HALF + wr * 64 + m * 16 + fr) * 2) * 4); const f32x4 p = pp[0], q = pp[1];
                    r0 = rsqrtf(((p[0] + p[1]) + (p[2] + p[3])) * rw2 * (1.f / 128.f) + EPS); r1 = rsqrtf(((q[0] + q[1]) + (q[2] + q[3])) * rw2 * (1.f / 128.f) + EPS); }
                r0 *= rw; r1 *= rw;
#pragma unroll
                for (int bj = 0; bj < 2; ++bj) { const float rr = bj ? r1 : r0; const f32x4 v0 = acc[ai][bj][m][0] * rr * gv0, v1 = acc[ai][bj][m][1] * rr * gv1;
                    u32x4 w; w.x = cvt_pk_bf16(v0[0], v0[1]); w.y = cvt_pk_bf16(v0[2], v0[3]); w.z = cvt_pk_bf16(v1[0], v1[1]); w.w = cvt_pk_bf16(v1[2], v1[3]);
                    *(GAS u32x4*)(rowp + bj * HALF) = w; } }
    }
};
struct EpiResid {
    static constexpr bool PERM = false;
    const GAS float* xf; const GAS bf16_t* hin; GAS float* outf; GAS bf16_t* hb; GAS float* ssq;
    LAS float* xch;
    __device__ __forceinline__ void operator()(const f32x4 (&acc)[2][2][4][2], const Unit& u, int wr, int wc, int fr, int fq) const {
        const int row0 = u.pm * BM + wr * 64 + fr, col0 = u.pn * BM + wc * 32 + 4 * fq;
#pragma unroll
        for (int ai = 0; ai < 2; ++ai) {
            u32x2 hw[4][2][2];
            if (!xf) {
#pragma unroll
                for (int m = 0; m < 4; ++m)
#pragma unroll
                    for (int bj = 0; bj < 2; ++bj)
#pragma unroll
                        for (int n = 0; n < 2; ++n) hw[m][bj][n] = *(const GAS u32x2*)(hin + (size_t)(row0 + ai * HALF + m * 16) * DM + col0 + bj * HALF + n * 16);
            }
#pragma unroll
            for (int mh = 0; mh < 2; ++mh) {
                f32x4 xs[2][2][2];
                if (xf) {
#pragma unroll
                    for (int mm = 0; mm < 2; ++mm)
#pragma unroll
                        for (int bj = 0; bj < 2; ++bj)
#pragma unroll
                            for (int n = 0; n < 2; ++n) xs[mm][bj][n] = *(const GAS f32x4*)(xf + (size_t)(row0 + ai * HALF + (2 * mh + mm) * 16) * DM + col0 + bj * HALF + n * 16);
                }
#pragma unroll
                for (int mm = 0; mm < 2; ++mm) { const int m = 2 * mh + mm; const int row = row0 + ai * HALF + m * 16; const size_t off = (size_t)row * DM + col0;
                    float sq = 0.f;
#pragma unroll
                    for (int bj = 0; bj < 2; ++bj)
#pragma unroll
                        for (int n = 0; n < 2; ++n) { f32x4 b4;
                            if (xf) b4 = xs[mm][bj][n];
                            else { const u32x2 w = hw[m][bj][n]; b4 = (f32x4){__uint_as_float(w.x << 16), __uint_as_float(w.x & 0xffff0000u), __uint_as_float(w.y << 16), __uint_as_float(w.y & 0xffff0000u)}; }
                            const f32x4 v = acc[ai][bj][m][n] + b4;
                            if (outf) *(GAS f32x4*)(outf + off + bj * HALF + n * 16) = v;
                            if (hb) { u32x2 w; w.x = cvt_pk_bf16(v[0], v[1]); w.y = cvt_pk_bf16(v[2], v[3]); *(GAS u32x2*)(hb + off + bj * HALF + n * 16) = w;
                                sq += (v[0] * v[0] + v[1] * v[1]) + (v[2] * v[2] + v[3] * v[3]); } }
                    if (hb) { sq += __shfl_xor(sq, 16); sq += __shfl_xor(sq, 32); if (fq == 0) xch[(ai * HALF + wr * 64 + m * 16 + fr) * 4 + wc] = sq; }
                }
                if (xf) asm volatile("" ::: "memory");
            }
            asm volatile("" ::: "memory");
        }
        if (hb) { LDS_WAIT(); __builtin_amdgcn_s_barrier(); asm volatile("" ::: "memory");
            const int t = wr * 256 + wc * 64 + fq * 16 + fr;
            if (t < 256) { const f32x4 p = *(const LAS f32x4*)(xch + t * 4); ssq[(size_t)(u.pm * BM + t) * 8 + u.pn] = (p[0] + p[1]) + (p[2] + p[3]); } }
    }
};
struct EpiRelu2 {
    static constexpr bool PERM = true;
    GAS bf16_t* O; const GAS float* ssq;
    __device__ __forceinline__ void operator()(const f32x4 (&acc)[2][2][4][2], const Unit& u, int wr, int wc, int fr, int fq) const {
        const int row0 = u.pm * BM + wr * 64 + fr, col0 = u.pn * BM + wc * 32 + 8 * fq;
        float sp[2][4];
#pragma unroll
        for (int ai = 0; ai < 2; ++ai)
#pragma unroll
            for (int m = 0; m < 4; ++m) { const GAS float* pp = ssq + (size_t)(row0 + ai * HALF + m * 16) * 8 + 2 * fq; sp[ai][m] = pp[0] + pp[1]; }
#pragma unroll
        for (int ai = 0; ai < 2; ++ai)
#pragma unroll
            for (int m = 0; m < 4; ++m) { GAS bf16_t* rowp = O + (size_t)(row0 + ai * HALF + m * 16) * FF + col0;
                float st = sp[ai][m]; st += __shfl_xor(st, 16); st += __shfl_xor(st, 32);
                const float r2 = 1.f / (st * (1.f / DM) + EPS);
#pragma unroll
                for (int bj = 0; bj < 2; ++bj) { f32x4 v0 = acc[ai][bj][m][0], v1 = acc[ai][bj][m][1];
#pragma unroll
                    for (int j = 0; j < 4; ++j) { v0[j] = fmaxf(v0[j], 0.f); v1[j] = fmaxf(v1[j], 0.f); }
                    v0 = v0 * v0 * r2; v1 = v1 * v1 * r2;
                    u32x4 w; w.x = cvt_pk_bf16(v0[0], v0[1]); w.y = cvt_pk_bf16(v0[2], v0[3]); w.z = cvt_pk_bf16(v1[0], v1[1]); w.w = cvt_pk_bf16(v1[2], v1[3]);
                    *(GAS u32x4*)(rowp + bj * HALF) = w; } }
    }
};

template <class Epi>
__device__ __forceinline__ void gemm_phase(LAS unsigned char* lds, Gemm g, const StaticOrder& S, const Epi& E) {
    int tid = threadIdx.x; asm volatile("" : "+v"(tid));
    asm volatile("" : "+s"(g.A), "+s"(g.Bt));
    const int wid = __builtin_amdgcn_readfirstlane(tid >> 6), lane = tid & 63, wr = wid >> 2, wc = wid & 3, fr = lane & 15, fq = lane >> 4;
    const int K = g.K, nt = K / BK;
    unsigned voffA[2], voffB[2];
#pragma unroll
    for (int i = 0; i < 2; ++i) { int R, C; stage_rc(tid * 16 + i * 8192, R, C); const int Rb = Epi::PERM ? ((R & ~31) + perm32(R & 31)) : R;
        voffA[i] = (unsigned)(R * K + C) * 2u; voffB[i] = (unsigned)(Rb * K + C) * 2u; }
    const size_t kstep = (size_t)(BK * 2);
    const size_t hstep = (size_t)HALF * K * 2;
    const size_t tstep = 2 * hstep;
    const unsigned ldsw = (unsigned)wid * 1024u;
    const int aoff = lds_byte(wr * 64 + fr, fq * 8), boff = lds_byte(wc * 32 + fr, fq * 8);
#define PG8_SA(b, h) (((b) * 2 + (h)) * HTB)
#define PG8_SB(b, h) ((4 + (b) * 2 + (h)) * HTB)
#define PG8_STAGE(bufoff, gbase, voff) do { _Pragma("unroll") for (int _i = 0; _i < 2; ++_i) \
        __builtin_amdgcn_global_load_lds((const GAS unsigned*)((const GAS char*)(gbase) + (voff)[_i]), (LAS unsigned*)(lds + (bufoff) + ldsw + _i * 8192), 16, 0, 0); } while (0)
#define PG8_LDA(dst, b, h) do { _Pragma("unroll") for (int m = 0; m < 4; ++m) _Pragma("unroll") for (int k = 0; k < 2; ++k) dst[m][k] = *(const LAS bf16x8*)(lds + PG8_SA(b, h) + aoff + m * 2048 + k * 1024); } while (0)
#define PG8_LDB(dst, b, h) do { _Pragma("unroll") for (int n = 0; n < 2; ++n) _Pragma("unroll") for (int k = 0; k < 2; ++k) dst[n][k] = *(const LAS bf16x8*)(lds + PG8_SB(b, h) + boff + n * 2048 + k * 1024); } while (0)
#define PG8_MMA(ai, bj, At, Bt) do { __builtin_amdgcn_s_setprio(1); _Pragma("unroll") for (int m = 0; m < 4; ++m) _Pragma("unroll") for (int n = 0; n < 2; ++n) _Pragma("unroll") for (int k = 0; k < 2; ++k) \
        acc[ai][bj][m][n] = __builtin_amdgcn_mfma_f32_16x16x32_bf16(Bt[n][k], At[m][k], acc[ai][bj][m][n], 0, 0, 0); __builtin_amdgcn_s_setprio(0); } while (0)
#define PG8_WAIT_V(n) asm volatile("s_waitcnt vmcnt(" #n ")" ::: "memory")
#define PG8_WAIT_L(n) asm volatile("s_waitcnt lgkmcnt(" #n ")" ::: "memory")
#define PG8_BAR __builtin_amdgcn_s_barrier()
#define PG8_SCHED __builtin_amdgcn_sched_barrier(0)
    Unit cur, nxt; int ui = 0;
    if (!S.next(0, cur)) return;
    if (STAGGER_TICKS > 0 && (S.c & 1)) { const unsigned long long t0_ = __builtin_amdgcn_s_memrealtime(); while (__builtin_amdgcn_s_memrealtime() - t0_ < (unsigned long long)STAGGER_TICKS) __builtin_amdgcn_s_sleep(16); }
    f32x4 acc[2][2][4][2];
#pragma unroll
    for (int a = 0; a < 2; ++a)
#pragma unroll
        for (int b = 0; b < 2; ++b)
#pragma unroll
            for (int m = 0; m < 4; ++m)
#pragma unroll
                for (int n = 0; n < 2; ++n) acc[a][b][m][n] = (f32x4){0.f, 0.f, 0.f, 0.f};
    bf16x8 At[4][2], B0[2][2], B1[2][2];
    const GAS char* cA = (const GAS char*)g.A + (size_t)cur.pm * tstep; const GAS char* cB = (const GAS char*)g.Bt + (size_t)cur.pn * tstep;
    PG8_STAGE(PG8_SB(0, 0), cB, voffB); PG8_STAGE(PG8_SB(0, 1), cB + hstep, voffB); PG8_STAGE(PG8_SA(0, 0), cA, voffA); PG8_STAGE(PG8_SA(0, 1), cA + hstep, voffA);
    if (wr == 1) PG8_BAR;
    PG8_WAIT_V(2); PG8_BAR;
    PG8_STAGE(PG8_SB(1, 0), cB + kstep, voffB); PG8_STAGE(PG8_SA(1, 0), cA + kstep, voffA); PG8_STAGE(PG8_SB(1, 1), cB + hstep + kstep, voffB);
    PG8_WAIT_V(6); PG8_BAR;
    for (;;) {
        const bool has_next = S.next(ui + 1, nxt);
        const GAS char* nA = has_next ? (const GAS char*)g.A + (size_t)nxt.pm * tstep : cA; const GAS char* nB = has_next ? (const GAS char*)g.Bt + (size_t)nxt.pn * tstep : cB;
        for (int t = 0; t < nt; t += 2) {
            const bool last = (t == nt - 2);
            const GAS char* a1 = cA + (size_t)(t + 1) * kstep;
            const GAS char* a2 = last ? nA : cA + (size_t)(t + 2) * kstep; const GAS char* b2 = last ? nB : cB + (size_t)(t + 2) * kstep;
            const GAS char* a3 = a2 + kstep; const GAS char* b3 = b2 + kstep;
            PG8_LDB(B0, 0, 0); PG8_LDB(B1, 0, 1); PG8_SCHED; PG8_LDA(At, 0, 0); PG8_STAGE(PG8_SA(1, 1), a1 + hstep, voffA);
            PG8_WAIT_V(8); PG8_WAIT_L(0); PG8_BAR; PG8_MMA(0, 0, At, B0); PG8_MMA(0, 1, At, B1); PG8_BAR; PG8_SCHED;
            PG8_LDA(At, 0, 1); PG8_STAGE(PG8_SB(0, 0), b2, voffB); PG8_STAGE(PG8_SB(0, 1), b2 + hstep, voffB); PG8_STAGE(PG8_SA(0, 0), a2, voffA);
            PG8_WAIT_V(8); PG8_WAIT_L(0); PG8_BAR; PG8_MMA(1, 0, At, B0); PG8_MMA(1, 1, At, B1); PG8_BAR; PG8_SCHED;
            PG8_LDB(B0, 1, 0); PG8_LDB(B1, 1, 1); PG8_SCHED; PG8_LDA(At, 1, 0); PG8_STAGE(PG8_SA(0, 1), a2 + hstep, voffA);
            PG8_WAIT_V(8); PG8_WAIT_L(0); PG8_BAR; PG8_MMA(0, 0, At, B0); PG8_MMA(0, 1, At, B1); PG8_BAR; PG8_SCHED;
            PG8_LDA(At, 1, 1); PG8_STAGE(PG8_SB(1, 0), b3, voffB); PG8_STAGE(PG8_SB(1, 1), b3 + hstep, voffB); PG8_STAGE(PG8_SA(1, 0), a3, voffA);
            PG8_WAIT_V(8); PG8_WAIT_L(0); PG8_BAR; PG8_MMA(1, 0, At, B0); PG8_MMA(1, 1, At, B1); PG8_BAR; PG8_SCHED;
        }
        if (wr == 0) PG8_BAR;
        E(acc, cur, wr, wc, fr, fq);
        if (!has_next) break;
#pragma unroll
        for (int a = 0; a < 2; ++a)
#pragma unroll
            for (int b = 0; b < 2; ++b)
#pragma unroll
                for (int m = 0; m < 4; ++m)
#pragma unroll
                    for (int n = 0; n < 2; ++n) acc[a][b][m][n] = (f32x4){0.f, 0.f, 0.f, 0.f};
        cur = nxt; cA = nA; cB = nB; ++ui;
        if (wr == 1) PG8_BAR;
    }
    PG8_WAIT_V(0);
    PG8_BAR;
#undef PG8_SA
#undef PG8_SB
#undef PG8_STAGE
#undef PG8_LDA
#undef PG8_LDB
#undef PG8_MMA
#undef PG8_WAIT_V
#undef PG8_WAIT_L
#undef PG8_BAR
#undef PG8_SCHED
}
}

namespace att {
constexpr int D = 128, RS = 2048, NW = 8, QBLK = 32, KVBLK = 64, QB = NW * QBLK;
constexpr int SHM_V = KVBLK * D * 2, SHM_K = KVBLK * D * 2;
constexpr int OFF_WS = 2 * SHM_V + 2 * SHM_K;
constexpr int OFF_BIAS = OFF_WS + NW * 64 * 4;
constexpr int OFF_OST = 86016, OST_WAVE = 16 * 272;
constexpr int CST = 648;
constexpr float THR = 40.f;

#define KSWZ(row, colB) ((row) * 256 + ((colB) ^ (((row) & 7) << 4)))
#define SBAR() __builtin_amdgcn_sched_barrier(0)
__device__ __forceinline__ int v_st(int k, int c) { const int kk = (k & ~0xC) | ((k & 4) << 1) | ((k & 8) >> 1); return ((kk >> 3) * 4 + (c >> 5)) * 512 + ((kk & 7) * 32 + (c & 31)) * 2; }
__device__ __forceinline__ int v_rd_base(int lane) { return ((lane & 3) << 3) | (((lane >> 2) & 3) << 6) | (((lane >> 4) & 1) << 5) | (((lane >> 5) & 1) << 8); }
constexpr int v_rd_off(int d0, int ks, int half) { return d0 * 512 + ks * 4096 + half * 2048; }
__device__ __forceinline__ int crow(int r, int hi) { return (r & 3) + 8 * (r >> 2) + 4 * hi; }
__device__ __forceinline__ unsigned cvtpk(float lo, float hi) { unsigned r; asm volatile("v_cvt_pk_bf16_f32 %0, %1, %2" : "=v"(r) : "v"(lo), "v"(hi)); return r; }
__device__ __forceinline__ bf16x8 load8(const GAS bf16_t* p) { return *(const GAS bf16x8*)(p); }

__device__ __forceinline__ void mask_tile(f32x16& p0, f32x16& p1, int dq, unsigned W) {
    const float NEG = -__builtin_inff();
#pragma unroll
    for (int r = 0; r < 16; ++r) {
        const int c = (r & 3) + 8 * (r >> 2);
        if ((unsigned)(dq - c) >= W) p0[r] = NEG;
        if ((unsigned)(dq - c - 32) >= W) p1[r] = NEG;
    }
}
__device__ __forceinline__ void partialSM(f32x16& p0, f32x16& p1, float& m_reg, float& mn, float& alpha) {
    float pmax = p0[0];
#pragma unroll
    for (int r = 1; r < 16; ++r) pmax = fmaxf(pmax, p0[r]);
#pragma unroll
    for (int r = 0; r < 16; ++r) pmax = fmaxf(pmax, p1[r]);
    { auto rr = __builtin_amdgcn_permlane32_swap(__float_as_uint(pmax), __float_as_uint(pmax), false, false);
      pmax = fmaxf(__uint_as_float(rr[0]), __uint_as_float(rr[1])); }
    constexpr float C2 = 1.4426950408889634f * SCALE;
    if (__builtin_expect(__all((pmax - m_reg) * SCALE <= THR), 1)) { mn = m_reg; alpha = 1.f; }
    else { mn = fmaxf(m_reg, pmax); alpha = __builtin_amdgcn_exp2f((m_reg - mn) * C2); m_reg = mn; }
    const float mnL = -mn * C2;
#pragma unroll
    for (int r = 0; r < 16; ++r) p0[r] = fmaf(p0[r], C2, mnL);
#pragma unroll
    for (int r = 0; r < 16; ++r) p1[r] = fmaf(p1[r], C2, mnL);
#pragma unroll
    for (int r = 0; r < 16; ++r) p0[r] = __builtin_amdgcn_exp2f(p0[r]);
}
__device__ __forceinline__ void finishSM(f32x16& p0, f32x16& p1, float alpha, float& l_reg, bf16x8& pa0, bf16x8& pa1, bf16x8& pa2, bf16x8& pa3) {
#pragma unroll
    for (int r = 0; r < 16; ++r) p1[r] = __builtin_amdgcn_exp2f(p1[r]);
    float ps = 0;
#pragma unroll
    for (int r = 0; r < 16; ++r) ps += p0[r];
#pragma unroll
    for (int r = 0; r < 16; ++r) ps += p1[r];
    { auto rr = __builtin_amdgcn_permlane32_swap(__float_as_uint(ps), __float_as_uint(ps), false, false);
      ps = __uint_as_float(rr[0]) + __uint_as_float(rr[1]); }
    l_reg = l_reg * alpha + ps;
#define PK4(P, B_, OUT) do { unsigned a0 = cvtpk(P[B_+0], P[B_+1]), a1 = cvtpk(P[B_+2], P[B_+3]);                          \
        unsigned b0 = cvtpk(P[B_+4], P[B_+5]), b1 = cvtpk(P[B_+6], P[B_+7]);                                             \
        auto r0 = __builtin_amdgcn_permlane32_swap(a0, b0, false, false); auto r1 = __builtin_amdgcn_permlane32_swap(a1, b1, false, false); \
        u32x4 w = {r0[0], r1[0], r0[1], r1[1]}; OUT = *reinterpret_cast<bf16x8*>(&w); } while (0)
    PK4(p0, 0, pa0); PK4(p0, 8, pa1); PK4(p1, 0, pa2); PK4(p1, 8, pa3);
#undef PK4
}
template <int KB, bool SK>
__device__ __forceinline__ void qkt(f32x16& p0, f32x16& p1, const char* K_lds, int r32, int hi, const bf16x8* qr, bool act, const char* bp) {
    if (SK && !act) { const float NEG = -__builtin_inff();
#pragma unroll
        for (int r = 0; r < 16; ++r) { p0[r] = NEG; p1[r] = NEG; } return; }
    { const f32x4 b0 = *(const f32x4*)(bp), b1 = *(const f32x4*)(bp + 32), b2 = *(const f32x4*)(bp + 64), b3 = *(const f32x4*)(bp + 96);
      const f32x4 b4 = *(const f32x4*)(bp + 128), b5 = *(const f32x4*)(bp + 160), b6 = *(const f32x4*)(bp + 192), b7 = *(const f32x4*)(bp + 224);
      p0 = (f32x16){b0[0], b0[1], b0[2], b0[3], b1[0], b1[1], b1[2], b1[3], b2[0], b2[1], b2[2], b2[3], b3[0], b3[1], b3[2], b3[3]};
      p1 = (f32x16){b4[0], b4[1], b4[2], b4[3], b5[0], b5[1], b5[2], b5[3], b6[0], b6[1], b6[2], b6[3], b7[0], b7[1], b7[2], b7[3]}; }
    const char* kb[4];
#pragma unroll
    for (int dd = 0; dd < 4; ++dd) kb[dd] = K_lds + KB * SHM_K + KSWZ(r32, (dd * 16 + hi * 8) * 2);
#pragma unroll
    for (int d0 = 0; d0 < 8; ++d0) { const char* a = kb[d0 & 3] + (d0 >> 2) * 128;
        bf16x8 b0 = *reinterpret_cast<const bf16x8*>(a);
        bf16x8 b1 = *reinterpret_cast<const bf16x8*>(a + 32 * 256);
        p0 = __builtin_amdgcn_mfma_f32_32x32x16_bf16(b0, qr[d0], p0, 0, 0, 0);
        p1 = __builtin_amdgcn_mfma_f32_32x32x16_bf16(b1, qr[d0], p1, 0, 0, 0); }
}
template <int VB, bool SK>
__device__ __forceinline__ void pv_tile(f32x16* o, int vb0, bf16x8 pa0, bf16x8 pa1, bf16x8 pa2, bf16x8 pa3, bool act) {
    if (SK && !act) return;
#define TRRD(dst, off) asm volatile("ds_read_b64_tr_b16 %0, %1 offset:%2" : "=&v"(dst) : "v"(vb0), "i"(off) : "memory")
#define PV_D0(d0) do { s16x4 l0, l1, l2, l3, h0, h1, h2, h3; constexpr int b_ = VB * SHM_V + v_rd_off(d0, 0, 0); \
        TRRD(l0, b_); TRRD(h0, b_ + 2048); TRRD(l1, b_ + 4096); TRRD(h1, b_ + 6144); TRRD(l2, b_ + 8192); TRRD(h2, b_ + 10240); TRRD(l3, b_ + 12288); TRRD(h3, b_ + 14336); \
        asm volatile("s_waitcnt lgkmcnt(0)" ::: "memory"); SBAR();   \
        o[d0] = __builtin_amdgcn_mfma_f32_32x32x16_bf16(pa0, (bf16x8){l0[0], l0[1], l0[2], l0[3], h0[0], h0[1], h0[2], h0[3]}, o[d0], 0, 0, 0);   \
        o[d0] = __builtin_amdgcn_mfma_f32_32x32x16_bf16(pa1, (bf16x8){l1[0], l1[1], l1[2], l1[3], h1[0], h1[1], h1[2], h1[3]}, o[d0], 0, 0, 0);   \
        o[d0] = __builtin_amdgcn_mfma_f32_32x32x16_bf16(pa2, (bf16x8){l2[0], l2[1], l2[2], l2[3], h2[0], h2[1], h2[2], h2[3]}, o[d0], 0, 0, 0);   \
        o[d0] = __builtin_amdgcn_mfma_f32_32x32x16_bf16(pa3, (bf16x8){l3[0], l3[1], l3[2], l3[3], h3[0], h3[1], h3[2], h3[3]}, o[d0], 0, 0, 0); } while (0)
    PV_D0(0); PV_D0(1); PV_D0(2); PV_D0(3);
#undef PV_D0
#undef TRRD
}

struct BlockRef { const GAS bf16_t* Q; const GAS bf16_t* K; const GAS bf16_t* V; GAS bf16_t* O; const GAS float* bt; int P0; int jl; };
struct Seam { bf16x8 qr[8]; bf16x8 st_v0, st_v1, st_k0, st_k1; };

#define ROW(p, k0, rr) ((p) + (size_t)((k0) + (rr)) * RS + sc)
#define VMW() asm volatile("s_waitcnt vmcnt(0)" ::: "memory")
#define VMWN(n) asm volatile("s_waitcnt vmcnt(%0)" :: "i"(n) : "memory")
#define SLOAD_H(Kp, Vp, k0) do { S.st_v0 = load8(ROW(Vp, k0, sr)); S.st_v1 = load8(ROW(Vp, k0, 32 + sr));              \
                         S.st_k0 = load8(ROW(Kp, k0, sr)); S.st_k1 = load8(ROW(Kp, k0, 32 + sr)); } while (0)
#define SWRITE_HK(bf) do { *(bf16x8*)(K_lds + (bf) * SHM_K + kws) = S.st_k0; *(bf16x8*)(K_lds + (bf) * SHM_K + kws + 32 * 256) = S.st_k1; } while (0)
#define SWRITE_HV(bf) do { *(bf16x8*)(V_lds + (bf) * SHM_V + vst0) = S.st_v0; *(bf16x8*)(V_lds + (bf) * SHM_V + vst1) = S.st_v1; } while (0)
#define SWRITE_H(bf) do { SWRITE_HV(bf); SWRITE_HK(bf); } while (0)

template <int MODE>
__device__ __forceinline__ void attn_prime(const BlockRef& cur, char* lds, Seam& S) {
    int tid = threadIdx.x; asm volatile("" : "+v"(tid));
    const int wid = __builtin_amdgcn_readfirstlane(tid >> 6), lane = tid & 63, r32 = lane & 31, hi = lane >> 5;
    const int sr = tid >> 4, sc = (tid & 15) * 8, kws = KSWZ(sr, sc * 2); char* K_lds = lds + 2 * SHM_V;
    const int kb0 = cur.jl * KVBLK;
#pragma unroll
    for (int d0 = 0; d0 < 8; ++d0) S.qr[d0] = load8(cur.Q + (size_t)(wid * QBLK + r32) * RS + d0 * 16 + hi * 8);
    SLOAD_H(cur.K, cur.V, kb0); VMW(); SWRITE_HK(0);
    __syncthreads();
}
template <int MODE>
__device__ __forceinline__ void attn_block(const BlockRef& cur, const BlockRef& nxt, char* lds, Seam& S, const bool newtab) {
    constexpr bool SK = (MODE == 1);
    int tid = threadIdx.x; asm volatile("" : "+v"(tid));
    const int wid = __builtin_amdgcn_readfirstlane(tid >> 6), lane = tid & 63, r32 = lane & 31, hi = lane >> 5;
    const int j_lo = cur.jl;
    const int j_hi = (cur.P0 >> 6) + 4;
    const int NT = j_hi - j_lo;
    const int kbn = nxt.jl * KVBLK;
    const int qlo = cur.P0 + wid * QBLK, qm = qlo + r32 - 4 * hi;
    const int cw = (cur.P0 >> 6) + (wid >> 1);
    char* V_lds = lds; char* K_lds = lds + 2 * SHM_V;
    float* ws = (float*)(lds + OFF_WS) + wid * 64; float* li_l = ws, * al_l = ws + 32;
    if (newtab) { float* tab = (float*)(lds + OFF_BIAS);
      if (MODE == 0) {
          _Pragma("clang loop vectorize(disable) unroll(disable)") for (int i = j_lo * KVBLK + tid; i < cur.P0 + QB; i += NW * 64) tab[i] = -cur.bt[i] * RSC; }
      else { _Pragma("clang loop vectorize(disable) unroll(disable)") for (int i = tid; i < 4 * CST; i += NW * 64) { const int a = i / CST, j = i - a * CST + a; int dist = 575 - j; dist = dist < -63 ? -63 : (dist > 256 ? 256 : dist);
                 tab[i] = cur.bt[dist + 63] * RSC; } }
      __syncthreads(); }
    int bl;
    if (MODE == 0) bl = OFF_BIAS + 16 * hi;
    else { const int tpos = cur.P0 + wid * QBLK + r32; const int a = (575 - tpos) & 3; bl = OFF_BIAS + a * (CST * 4) + 4 * (575 - tpos - a + 4 * hi); }
    asm volatile("" : "+v"(bl));
    float m_reg = -1e30f, l_reg = 0; f32x16 o[4] = {};
    if (wid >= 4) __builtin_amdgcn_s_setprio(1);
    const int sr = tid >> 4, sc = (tid & 15) * 8, vst0 = v_st(sr, sc), vst1 = v_st(32 + sr, sc), kws = KSWZ(sr, sc * 2);
    const int vb0 = (int)(uintptr_t)V_lds + v_rd_base(lane);
    const GAS bf16_t* Kh = cur.K; const GAS bf16_t* Vh = cur.V;
#define RESC(a) do { if (__any((a) < 1.f)) { if (hi == 0) al_l[r32] = (a); asm volatile("s_waitcnt lgkmcnt(0)" ::: "memory");              \
                     for (int d_ = 0; d_ < 4; ++d_) for (int r = 0; r < 16; ++r) o[d_][r] *= al_l[crow(r, hi)]; } } while (0)
#define KBASE(t) ((j_lo + (t)) * KVBLK)
#define BP(t) (lds + (bl + ((MODE == 0 || ACT(t)) ? KBASE(t) : cw * KVBLK) * 4))
#define ACT(t) (MODE == 0 ? true : ((j_lo + (t)) <= cw && (j_lo + (t)) >= cw - 8))
#define MASKT(P0_, P1_, t) do { if (MODE == 0) { const int kb_ = KBASE(t); if (kb_ + KVBLK - 1 > qlo) mask_tile(P0_, P1_, qm - kb_, 0x7fffffffu); } \
        else if (!ACT(t)) { const float NEG_ = -__builtin_inff(); _Pragma("unroll") for (int r_ = 0; r_ < 16; ++r_) { P0_[r_] = NEG_; P1_[r_] = NEG_; } } } while (0)
    constexpr int NQL = 8;
#define PSM(P0_, P1_, mn_, al_, t_) do { if (MODE == 1 && !ACT(t_)) { al_ = 1.f; } else partialSM(P0_, P1_, m_reg, mn_, al_); } while (0)
#define FSM(P0_, P1_, al_, t_) do { if (!(MODE == 1 && !ACT(t_))) finishSM(P0_, P1_, al_, l_reg, pa0, pa1, pa2, pa3); } while (0)
#define SEAM_K0() do { VMWN(NQL); SWRITE_HK(0); SBAR(); } while (0)
    f32x16 pA0, pA1, pB0, pB1; float mnA, mnB, alA, alB; bf16x8 pa0, pa1, pa2, pa3;
    SWRITE_HV(0); SBAR();
    if (NT > 1) { SLOAD_H(Kh, Vh, KBASE(1)); }
    SBAR(); qkt<0, SK>(pA0, pA1, K_lds, r32, hi, S.qr, ACT(0), BP(0));
    MASKT(pA0, pA1, 0); PSM(pA0, pA1, mnA, alA, 0);
    if (NT > 1) { VMW(); SWRITE_H(1); }
    __syncthreads();
#define HALF_STEP(PX0, PX1, mnX, alX, PY0, PY1, alY, t, KB, VB, SB) do {                                                      \
        SBAR(); qkt<KB, SK>(PX0, PX1, K_lds, r32, hi, S.qr, ACT(t), BP(t));                                      \
        FSM(PY0, PY1, alY, (t) - 1); SBAR();                                                                                  \
        if ((t) + 1 < NT) { SLOAD_H(Kh, Vh, KBASE((t) + 1)); SBAR(); }                                                        \
        pv_tile<VB, SK>(o, vb0, pa0, pa1, pa2, pa3, ACT((t) - 1)); MASKT(PX0, PX1, (t)); PSM(PX0, PX1, mnX, alX, (t));          \
        __syncthreads();                                                                                                      \
        if ((t) + 1 < NT) { VMW(); SWRITE_H(SB); }                                                                            \
        RESC(alX); __syncthreads(); } while (0)
    for (int t = 1; t + 1 < NT; t += 2) {
        HALF_STEP(pB0, pB1, mnB, alB, pA0, pA1, alA, t, 1, 0, 0);
        HALF_STEP(pA0, pA1, mnA, alA, pB0, pB1, alB, t + 1, 0, 1, 1);
    }
    const bool even = (NT & 1) == 0;
    if (even) { SBAR(); qkt<1, SK>(pB0, pB1, K_lds, r32, hi, S.qr, ACT(NT - 1), BP(NT - 1)); SBAR(); }
    SLOAD_H(nxt.K, nxt.V, kbn); SBAR();
#pragma unroll
    for (int d0 = 0; d0 < 8; ++d0) S.qr[d0] = load8(nxt.Q + (size_t)(wid * QBLK + r32) * RS + d0 * 16 + hi * 8);
    SBAR();
    FSM(pA0, pA1, alA, (even ? NT - 2 : NT - 1)); SBAR();
    pv_tile<0, SK>(o, vb0, pa0, pa1, pa2, pa3, ACT(even ? NT - 2 : NT - 1));
    if (even) { MASKT(pB0, pB1, NT - 1); PSM(pB0, pB1, mnB, alB, NT - 1); __syncthreads(); RESC(alB);
        FSM(pB0, pB1, alB, NT - 1); SBAR(); pv_tile<1, SK>(o, vb0, pa0, pa1, pa2, pa3, ACT(NT - 1)); }
    SBAR(); SEAM_K0();
    if (hi == 0) li_l[r32] = l_reg; asm volatile("s_waitcnt lgkmcnt(0)" ::: "memory");
    float rli[16];
#pragma unroll
    for (int r = 0; r < 16; ++r) rli[r] = __builtin_amdgcn_rcpf(li_l[crow(r, hi)]);
    GAS bf16_t* Ow = cur.O + (size_t)(wid * QBLK) * RS;
    char* ost = lds + OFF_OST + wid * OST_WAVE;
#pragma unroll
    for (int p = 0; p < 2; ++p) {
#pragma unroll
        for (int rr = 0; rr < 8; ++rr) { const int r = 8 * p + rr; const int lrow = crow(r, hi) - 16 * p;
#pragma unroll
            for (int d0 = 0; d0 < 4; ++d0) { const float v = o[d0][r] * rli[r]; const unsigned w = cvtpk(v, v);
                *(unsigned short*)(ost + lrow * 272 + (d0 * 32 + r32) * 2) = (unsigned short)w; } }
        asm volatile("s_waitcnt lgkmcnt(0)" ::: "memory");
#pragma unroll
        for (int k = 0; k < 4; ++k) { const int row = (lane >> 4) + 4 * k; const u32x4 w = *(const u32x4*)(ost + row * 272 + (lane & 15) * 16);
            *(GAS u32x4*)(Ow + (size_t)(16 * p + row) * RS + (lane & 15) * 8) = w; }
        asm volatile("s_waitcnt lgkmcnt(0)" ::: "memory");
    }
    if (wid >= 4) __builtin_amdgcn_s_setprio(0);
    __syncthreads();
#undef RESC
#undef KBASE
#undef BP
#undef ACT
#undef MASKT
#undef SEAM_K0
#undef PSM
#undef FSM
#undef HALF_STEP
}
#undef ROW
#undef VMW
#undef VMWN
#undef SLOAD_H
#undef SWRITE_HK
#undef SWRITE_HV
#undef SWRITE_H

template <int MODE>
__device__ __forceinline__ BlockRef block_ref(int n, int vcu, int G, const GAS bf16_t* Q, const GAS bf16_t* K, const GAS bf16_t* V, GAS bf16_t* O, const GAS float* bt, const GAS int* jtab) {
    int bh, qb;
    if (MODE == 0) {
        if (G == 2 * BATCH * NH) { bh = vcu >> 1; const int p = n >> 1; qb = (vcu & 1) ? ((n & 1) ? 13 - 4 * p : 14 - 4 * p) : ((n & 1) ? 12 - 4 * p : 15 - 4 * p); }
        else { const int L = vcu + n * G; bh = L >> 4; qb = 15 - (L & 15); }
    } else {
        if (G == 2 * BATCH * NH) { bh = vcu >> 1; qb = (vcu & 1) ? (n == 0 ? 1 : n + 8) : (n == 0 ? 0 : n + 1); }
        else { const int L = vcu + n * G; bh = L >> 4; qb = L & 15; }
    }
    const int b = bh >> 4, h = bh & 15;
    BlockRef r; const size_t row0 = (size_t)b * SEQ;
    r.Q = Q + (row0 + (size_t)qb * QB) * RS + h * D; r.O = O + (row0 + (size_t)qb * QB) * RS + h * D;
    r.K = K + row0 * RS + h * D; r.V = V + row0 * RS + h * D; r.P0 = qb * QB;
    r.bt = MODE == 0 ? bt + (size_t)bh * SEQ : bt + h * NREL;
    if (MODE == 0) r.jl = jtab[bh * 16 + qb]; else { const int j = (r.P0 >> 6) - 8; r.jl = j > 0 ? j : 0; }
    return r;
}
template <int MODE>
__device__ __forceinline__ void attn_phase(char* lds, int vcu, int G, const GAS bf16_t* Q, const GAS bf16_t* K, const GAS bf16_t* V, GAS bf16_t* O, const GAS float* bt, const GAS int* jtab) {
    asm volatile("" : "+s"(Q), "+s"(K), "+s"(V), "+s"(O), "+s"(bt), "+s"(vcu), "+s"(jtab), "+s"(G));
    const int total = BATCH * NH * 16;
    int nblk = 0; for (int L = vcu; L < total; L += G) ++nblk;
    if (nblk == 0) return;
    BlockRef cur = block_ref<MODE>(0, vcu, G, Q, K, V, O, bt, jtab);
    Seam S;
    attn_prime<MODE>(cur, lds, S);
    const GAS float* prev_bt = nullptr;
    for (int n = 0; n < nblk; ++n) {
        const bool last = (n + 1 == nblk);
        const BlockRef nxt = last ? cur : block_ref<MODE>(n + 1, vcu, G, Q, K, V, O, bt, jtab);
        attn_block<MODE>(cur, nxt, lds, S, cur.bt != prev_bt);
        prev_bt = cur.bt; cur = nxt;
    }
}
__device__ __forceinline__ BlockRef ticket_ref(int ticket, const GAS bf16_t* Q, const GAS bf16_t* K, const GAS bf16_t* V, GAS bf16_t* O, const GAS float* bt, const GAS int* jtab) {
    const int q = ticket >> 8, i = ticket & 255, qb = 15 - (i >> 4), bh = q * 16 + (i & 15);
    const int b = bh >> 4, h = bh & 15;
    BlockRef r; const size_t row0 = (size_t)b * SEQ;
    r.Q = Q + (row0 + (size_t)qb * QB) * RS + h * D; r.O = O + (row0 + (size_t)qb * QB) * RS + h * D;
    r.K = K + row0 * RS + h * D; r.V = V + row0 * RS + h * D; r.P0 = qb * QB;
    r.bt = bt + (size_t)bh * SEQ; r.jl = jtab[bh * 16 + qb];
    return r;
}
__device__ __forceinline__ void attn_phase_dyn(char* lds, GAS unsigned* qc  , const GAS bf16_t* Q, const GAS bf16_t* K, const GAS bf16_t* V, GAS bf16_t* O, const GAS float* bt, const GAS int* jtab) {
    asm volatile("" : "+s"(Q), "+s"(K), "+s"(V), "+s"(O), "+s"(bt), "+s"(jtab), "+s"(qc));
    volatile LAS int* tk = (volatile LAS int*)(LAS char*)(lds + OFF_BIAS + 16384 + 64);
    const unsigned xq = (unsigned)__builtin_amdgcn_s_getreg((3 << 11) | 20) & 7u;
    int slot = 0; if (threadIdx.x == 0) tk[2] = 0;
#define TK_PULL(out) do { if (threadIdx.x == 0) { unsigned t_ = 256u, kq = (unsigned)tk[2]; for (;;) { t_ = __hip_atomic_fetch_add(qc + 64 * ((xq + kq) & 7u), 1u, __ATOMIC_RELAXED, __HIP_MEMORY_SCOPE_AGENT); if (t_ < 256u || kq >= 7u) break; ++kq; } \
            tk[2] = (int)kq; tk[slot] = (t_ < 256u) ? (int)((((xq + kq) & 7u) << 8) | t_) : -1; } \
        __syncthreads(); out = __builtin_amdgcn_readfirstlane(tk[slot]); slot ^= 1; } while (0)
    int tc, tn;
    TK_PULL(tc); if (tc < 0) return;
    TK_PULL(tn);
    BlockRef cur = ticket_ref(tc, Q, K, V, O, bt, jtab);
    Seam S;
    attn_prime<0>(cur, lds, S);
    for (;;) {
        const bool last = tn < 0;
        const BlockRef nxt = last ? cur : ticket_ref(tn, Q, K, V, O, bt, jtab);
        attn_block<0>(cur, nxt, lds, S, true);
        if (last) break;
        cur = nxt; TK_PULL(tn);
    }
#undef TK_PULL
}
}


#define XB_TMO      128
#define XB_XCNT(j)  (256  + 64 * (j))
#define XB_XSUB(j)  (1280 + 64 * (j))
#define XB_XGEN(j)  (2304 + 64 * (j))
#define XB_TOP      3328
#define XB_TOPGEN   3392
#define XCD_BAR_WORDS 3456
#define XB_SPIN_CAP (1u << 18)
__device__ __forceinline__ unsigned xb_ld(unsigned* p)              { return __hip_atomic_load(p, __ATOMIC_RELAXED, __HIP_MEMORY_SCOPE_AGENT); }
__device__ __forceinline__ unsigned xb_add(unsigned* p, unsigned v) { return __hip_atomic_fetch_add(p, v, __ATOMIC_RELAXED, __HIP_MEMORY_SCOPE_AGENT); }
__device__ __forceinline__ unsigned xb_xcc_id() { return (unsigned)__builtin_amdgcn_s_getreg((3 << 11) | 20) & 0xFu; }
#define XB_SPIN(cond, bar) do { unsigned _sp = 0; while (cond) { __builtin_amdgcn_s_sleep(1); \
    if ((++_sp & 255u) == 0u) { if (xb_ld(&(bar)[XB_TMO])) break; if (_sp > XB_SPIN_CAP) { atomicAdd(&(bar)[XB_TMO], 1u); break; } } } } while (0)
struct XcdBarrier { unsigned* bar; unsigned x; volatile LAS unsigned* st; };
__device__ __forceinline__ XcdBarrier xcd_barrier_post(unsigned* bar, volatile LAS unsigned* st) {
    XcdBarrier b; b.bar = bar; b.x = xb_xcc_id(); b.st = st;
    if (threadIdx.x == 0) (void)xb_add(&bar[XB_XCNT(b.x)], 1u);
    return b;
}
__device__ __forceinline__ void xcd_barrier_complete(unsigned* bar, unsigned x, unsigned& nloc, unsigned& nx) {
    const unsigned G = gridDim.x * gridDim.y * gridDim.z;
    unsigned sum, cnt, mine, sp = 0u;
    for (;;) {
        sum = 0u; cnt = 0u; mine = 0u;
#pragma unroll
        for (unsigned j = 0; j < 16; ++j) { const unsigned c = xb_ld(&bar[XB_XCNT(j)]); sum += c; cnt += (c > 0u) ? 1u : 0u; mine = (j == x) ? c : mine; }
        if (sum == G) break;
        __builtin_amdgcn_s_sleep(1);
        if ((++sp & 255u) == 0u) { if (xb_ld(&bar[XB_TMO])) break; if (sp > XB_SPIN_CAP) { atomicAdd(&bar[XB_TMO], 1u); break; } }
    }
    nloc = mine > 0u ? mine : 1u; nx = cnt > 0u ? cnt : 1u;
}
__device__ __forceinline__ void xcd_barrier(const XcdBarrier& b) {
    asm volatile("s_waitcnt vmcnt(0)" ::: "memory");
    __syncthreads();
    if (threadIdx.x == 0) {
        unsigned* bar = b.bar;
        __builtin_amdgcn_s_waitcnt(0);
        unsigned nloc = b.st[0], nx = b.st[1];
        if (nloc == 0u) { xcd_barrier_complete(bar, b.x, nloc, nx); b.st[0] = nloc; b.st[1] = nx; }
        const unsigned old = xb_add(&bar[XB_XSUB(b.x)], 1u);
        const unsigned gen = old / nloc;
        if (old + 1u == (gen + 1u) * nloc) {
            __builtin_amdgcn_fence(__ATOMIC_RELEASE, "agent");
            asm volatile("s_waitcnt vmcnt(0)" ::: "memory");
            const unsigned og = xb_add(&bar[XB_TOP], 1u);
            const unsigned tg = og / nx;
            if (og + 1u == (tg + 1u) * nx) xb_add(&bar[XB_TOPGEN], 1u);
            else XB_SPIN(xb_ld(&bar[XB_TOPGEN]) == tg, bar);
            __builtin_amdgcn_fence(__ATOMIC_ACQUIRE, "agent");
            xb_add(&bar[XB_XGEN(b.x)], 1u);
            asm volatile("s_waitcnt vmcnt(0)" ::: "memory");
        } else {
            XB_SPIN(xb_ld(&bar[XB_XGEN(b.x)]) == gen, bar);
            __builtin_amdgcn_fence(__ATOMIC_ACQUIRE, "agent");
            asm volatile("s_waitcnt vmcnt(0)" ::: "memory");
        }
    }
    __syncthreads();
}

__device__ __forceinline__ float wave_sum(float v) {
#pragma unroll
    for (int o = 1; o < 64; o <<= 1) v += __shfl_xor(v, o);
    return v;
}
__device__ __forceinline__ unsigned f2bf(float f) { unsigned u = __builtin_bit_cast(unsigned, f); return (u + 0x7fffu + ((u >> 16) & 1u)) >> 16; }
__device__ __forceinline__ unsigned pk2(float lo, float hi) { return f2bf(lo) | (f2bf(hi) << 16); }
__device__ __forceinline__ void transpose_item(const GAS float* W, int K, int N, int ldn, const GAS float* gk, GAS bf16_t* WT, int row_off, LAS float* scr, int item, int nblk, int lane) {
    const int kb = item / nblk, nb = item - kb * nblk, k0 = 64 * kb, n0 = 32 * nb;
    const int n = n0 + (lane & 31);
    float wv[32];
#pragma unroll
    for (int i = 0; i < 32; ++i) wv[i] = 0.f;
    if (n0 + 32 <= N) {
#pragma unroll
        for (int i = 0; i < 32; ++i) { const int kk = 2 * i + (lane >> 5); wv[i] = __builtin_nontemporal_load(W + (size_t)(k0 + kk) * ldn + n); }
    } else if (n0 < N) {
#pragma unroll
        for (int i = 0; i < 32; ++i) { const int kk = 2 * i + (lane >> 5); if (n < N) wv[i] = __builtin_nontemporal_load(W + (size_t)(k0 + kk) * ldn + n); }
    }
#pragma unroll
    for (int i = 0; i < 32; ++i) { const int kk = 2 * i + (lane >> 5); float v = wv[i]; if (gk) v *= gk[k0 + kk]; scr[kk * 33 + (lane & 31)] = v; }
    LDS_WAIT(); asm volatile("" ::: "memory");
    const int c = lane & 7;
#pragma unroll
    for (int j = 0; j < 4; ++j) { const int nn = (lane >> 3) + 8 * j; const LAS float* s = scr + (8 * c) * 33 + nn;
        u32x4 o; o.x = pk2(s[0 * 33], s[1 * 33]); o.y = pk2(s[2 * 33], s[3 * 33]); o.z = pk2(s[4 * 33], s[5 * 33]); o.w = pk2(s[6 * 33], s[7 * 33]);
        *(GAS u32x4*)(WT + (size_t)(row_off + n0 + nn) * K + k0 + 8 * c) = o; }
    LDS_WAIT(); asm volatile("" ::: "memory");
}
__device__ __forceinline__ void seed_row(const GAS float* xrow, GAS bf16_t* orow, GAS float* ssq8, int lane) {
    asm volatile("" : "+v"(lane));
    const GAS f32x4* xr = (const GAS f32x4*)xrow + lane;
    f32x4 v[8]; float s = 0.f;
#pragma unroll
    for (int j = 0; j < 8; ++j) { v[j] = xr[64 * j]; s += (v[j][0] * v[j][0] + v[j][1] * v[j][1]) + (v[j][2] * v[j][2] + v[j][3] * v[j][3]); }
    GAS u32x2* o8 = (GAS u32x2*)orow + lane;
#pragma unroll
    for (int j = 0; j < 8; ++j) { u32x2 w; w.x = pk2(v[j][0], v[j][1]); w.y = pk2(v[j][2], v[j][3]); o8[64 * j] = w; }
    s = wave_sum(s);
    if (lane < 8) ssq8[lane] = lane == 0 ? s : 0.f;
}

struct Args { const float* in[18]; float* out; unsigned char* ws; };
enum { I_X = 0, I_ANG, I_AWIN, I_ABF, I_AQG, I_AKG, I_AWOUT, I_MNG, I_W1, I_W2, I_KVNG, I_KVW, I_KVKG, I_BNG, I_BWQ, I_BQG, I_BREL, I_BWOUT };

__global__ void __launch_bounds__(512, 2) fwd_megakernel(Args a) {
    extern __shared__ __attribute__((aligned(16))) unsigned char lds[];
    cg::grid_group grid = cg::this_grid();
    LAS unsigned char* L = (LAS unsigned char*)lds;
    const int wave = __builtin_amdgcn_readfirstlane(threadIdx.x >> 6);
    const int G = gridDim.x, bx = blockIdx.x;
    const int vcu = (G % 8 == 0) ? (bx % 8) * (G / 8) + bx / 8 : bx;
    GAS unsigned char* ws = (GAS unsigned char*)a.ws;
    GAS float* LF = (GAS float*)(ws + WS_LF); GAS float* GT = (GAS float*)(ws + WS_GT); GAS int* JT = (GAS int*)(ws + WS_GT + 8192);
    GAS bf16_t* WIN = (GAS bf16_t*)(ws + WS_WIN); GAS bf16_t* WOA = (GAS bf16_t*)(ws + WS_WOA); GAS bf16_t* W1T = (GAS bf16_t*)(ws + WS_W1); GAS bf16_t* W2T = (GAS bf16_t*)(ws + WS_W2);
    GAS bf16_t* WKVQ = (GAS bf16_t*)(ws + WS_WKVQ); GAS bf16_t* WOB = (GAS bf16_t*)(ws + WS_WOB);
    GAS bf16_t* U2 = (GAS bf16_t*)(ws + WS_U2); GAS float* SSQ = (GAS float*)(ws + WS_SSQ);
    GAS bf16_t* U = (GAS bf16_t*)(ws + WS_U); GAS bf16_t* QKV = (GAS bf16_t*)(ws + WS_QKV); GAS bf16_t* HID = QKV;
    GAS float* out = (GAS float*)a.out;
#define IN(i) ((const GAS float*)a.in[i])
    const int gw = vcu * 8 + wave, NGW = G * 8;
    if (threadIdx.x < 4) ((LAS unsigned*)(L + BARW_OFF))[threadIdx.x] = 0u;
    __syncthreads();
    if (bx == 0) for (int i = threadIdx.x; i < 4096; i += 512) ((GAS unsigned*)a.ws)[i] = 0u;
#define GRID_BAR() xcd_barrier(xbar)

    constexpr int I0 = 32 * 200, I1 = 32 * 64, I2 = 32 * 256, I3 = 128 * 64, I4 = 32 * 128, I5 = 32 * 64, I6 = 32 * 64;
    constexpr int NP0 = I0 + I1 + 2 * I2 + I3 + I4 + I5, NDEF = I3 + I6;
    for (int rep_ = 0; rep_ < (PROBE_REPEAT == 1 ? 2 : 1); ++rep_) {
        int tid = threadIdx.x; asm volatile("" : "+v"(tid)); const int lane = tid & 63;
        LAS float* scr = (LAS float*)(L + wave * 16384);
        for (int it = gw; it < NP0; it += NGW) {
            int r = it;
            if (r < I0) { transpose_item(IN(I_AWIN), DM, 3 * DM + NH, 3 * DM + NH, IN(I_ANG), WIN, 0, scr, r, 200, lane); continue; } r -= I0;
            if (r < I1) { transpose_item(IN(I_AWOUT), DM, DM, DM, nullptr, WOA, 0, scr, r, 64, lane); continue; } r -= I1;
            if (r < I2) { transpose_item(IN(I_W1), DM, FF, FF, IN(I_MNG), W1T, 0, scr, r, 256, lane); continue; } r -= I2;
            if (r < I2) { transpose_item(IN(I_W1) + (size_t)DM * FF, DM, FF, FF, IN(I_MNG) + DM, W1T + (size_t)FF * DM, 0, scr, r, 256, lane); continue; } r -= I2;
            if (r < I3) { transpose_item(IN(I_W2), FF, DM, DM, nullptr, W2T, 0, scr, r, 64, lane); continue; } r -= I3;
            if (r < I4) { transpose_item(IN(I_KVW), DM, 2 * DM, 2 * DM, IN(I_KVNG), WKVQ, 0, scr, r, 128, lane); continue; } r -= I4;
            transpose_item(IN(I_BWQ), DM, DM, DM, IN(I_BNG), WKVQ, 2 * DM, scr, r, 64, lane);
        }
        for (int m = gw; m < M; m += NGW) seed_row(IN(I_X) + (size_t)m * DM, U2 + (size_t)m * DM, SSQ + (size_t)24 * M + (size_t)m * 8, lane);
        if (bx == 0 && tid < HD) { GT[tid] = IN(I_AQG)[tid]; GT[HD + tid] = IN(I_AKG)[tid]; GT[2 * HD + tid] = 1.f;
            GT[3 * HD + tid] = IN(I_KVKG)[tid]; GT[4 * HD + tid] = 1.f; GT[5 * HD + tid] = IN(I_BQG)[tid]; }
    }
    grid.sync();
    const XcdBarrier xbar = xcd_barrier_post((unsigned*)a.ws, (volatile LAS unsigned*)(L + BARW_OFF));

    {
        pg8::Gemm g{U2, WIN, M, NIN_A, DM}; pg8::StaticOrder S; S.init(M, NIN_A, G, bx);
        pg8::EpiQKV E{QKV, GT, 3, LF, IN(I_ABF), SSQ + (size_t)24 * M, (LAS float*)(L + XCH_OFF)};
#ifndef NO_EPIQKV_1
        pg8::gemm_phase<pg8::EpiQKV>(L, g, S, E);
#endif
    }
    {
        const int rr = ((M / 256) * (NIN_A / 256)) % G;
        int didx = -1, dstride = 1;
        if (rr == 0) { didx = bx * 8 + wave; dstride = G * 8; } else if (bx >= rr) { didx = (bx - rr) * 8 + wave; dstride = (G - rr) * 8; }
        if (didx >= 0) {
            int tid = threadIdx.x; asm volatile("" : "+v"(tid)); const int lane = tid & 63;
            LAS float* scr = (LAS float*)(L + wave * 16384);
            for (int it = didx; it < NDEF; it += dstride) {
                if (it < I3) transpose_item(IN(I_W2) + (size_t)FF * DM, FF, DM, DM, nullptr, W2T + (size_t)DM * FF, 0, scr, it, 64, lane);
                else transpose_item(IN(I_BWOUT), DM, DM, DM, nullptr, WOB, 0, scr, it - I3, 64, lane);
            }
        }
    }
    GRID_BAR();

    if (bx < BATCH * NH) {
        int tid = threadIdx.x; asm volatile("" : "+v"(tid)); const int lane = tid & 63;
        GAS float* p = LF + (size_t)bx * SEQ + tid * 8;
        f32x4 v0 = *(const GAS f32x4*)p, v1 = *(const GAS f32x4*)(p + 4);
        v0[1] += v0[0]; v0[2] += v0[1]; v0[3] += v0[2]; v1[0] += v0[3]; v1[1] += v1[0]; v1[2] += v1[1]; v1[3] += v1[2];
        const float tot = v1[3]; float x = tot;
#pragma unroll
        for (int o = 1; o < 64; o <<= 1) { const float t = __shfl_up(x, o); if (lane >= o) x += t; }
        LAS float* wt = (LAS float*)L;
        LAS float* cs = (LAS float*)(L + 256);
        if (lane == 63) wt[wave] = x;
        float gq = 0.f, gk = 0.f;
        if (tid < 64) { gq = fmaxf(fabsf(GT[tid]), fabsf(GT[tid + 64])); gk = fmaxf(fabsf(GT[HD + tid]), fabsf(GT[HD + tid + 64]));
#pragma unroll
            for (int o = 1; o < 64; o <<= 1) { gq = fmaxf(gq, __shfl_xor(gq, o)); gk = fmaxf(gk, __shfl_xor(gk, o)); }
            if (tid == 0) wt[8] = 2.f * 1.02f * RSC * gq * gk + 26.f; }
        __syncthreads();
        float off = x - tot;
        for (int w = 0; w < wave; ++w) off += wt[w];
        v0 = v0 + off; v1 = v1 + off;
        *(GAS f32x4*)p = v0; *(GAS f32x4*)(p + 4) = v1;
        *(LAS f32x4*)(cs + tid * 8) = v0; *(LAS f32x4*)(cs + tid * 8 + 4) = v1;
        __syncthreads();
        if (tid < 16) { const int P0 = tid * 256; const float cq = cs[P0], T = wt[8]; int t = 0;
            while (t < (P0 >> 6) && cq - cs[64 * t + 63] < -T) ++t;
            JT[bx * 16 + tid] = t; }
    }
    GRID_BAR();

#ifndef NO_ATT0
    att::attn_phase_dyn((char*)lds, (GAS unsigned*)a.ws + 3520, QKV, QKV + SEG, QKV + 2 * SEG, U, LF, JT);
#endif
#if PROBE_REPEAT == 3
    __syncthreads(); att::attn_phase<0>((char*)lds, vcu, G, QKV, QKV + SEG, QKV + 2 * SEG, U, LF, JT);
#endif
    GRID_BAR();

    {
        pg8::Gemm g{U, WOA, M, DM, DM}; pg8::StaticOrder S; S.init(M, DM, G, bx);
        pg8::EpiResid E{nullptr, U2, nullptr, U2, SSQ, (LAS float*)(L + XCH_OFF)};
#ifndef NO_EPIRESID_1
        pg8::gemm_phase<pg8::EpiResid>(L, g, S, E);
#endif
    }
    GRID_BAR();

#define MLP_BLOCK(layer, SSQ_IN, OUTF, HB_OUT, SSQ_OUT) do { \
        { pg8::Gemm g{U2, W1T + (size_t)(layer) * FF * DM, M, FF, DM}; pg8::StaticOrder S; S.init(M, FF, G, bx); \
          pg8::EpiRelu2 E{HID, SSQ_IN}; \
          pg8::gemm_phase<pg8::EpiRelu2>(L, g, S, E); \
          if (PROBE_REPEAT == 6 && (layer) == 0) { __syncthreads(); pg8::gemm_phase<pg8::EpiRelu2>(L, g, S, E); } } \
        GRID_BAR(); \
        { pg8::Gemm g{HID, W2T + (size_t)(layer) * DM * FF, M, DM, FF}; pg8::StaticOrder S; S.init(M, DM, G, bx); \
          pg8::EpiResid E{nullptr, U2, OUTF, HB_OUT, SSQ_OUT, (LAS float*)(L + XCH_OFF)}; \
          pg8::gemm_phase<pg8::EpiResid>(L, g, S, E); } } while (0)
    MLP_BLOCK(0, SSQ, (GAS float*)nullptr, U2, SSQ + (size_t)8 * M);
    GRID_BAR();
    {
        pg8::Gemm g{U2, WKVQ, M, NIN_B, DM}; pg8::StaticOrder S; S.init(M, NIN_B, G, bx);
        pg8::EpiQKV E{QKV, GT + 3 * HD, 5, nullptr, nullptr, SSQ + (size_t)8 * M, (LAS float*)(L + XCH_OFF)};
        pg8::gemm_phase<pg8::EpiQKV>(L, g, S, E);
    }
    GRID_BAR();
    att::attn_phase<1>((char*)lds, vcu, G, QKV + 2 * SEG, QKV, QKV + SEG, U, IN(I_BREL), JT);
#if PROBE_REPEAT == 10
    __syncthreads(); att::attn_phase<1>((char*)lds, vcu, G, QKV + 2 * SEG, QKV, QKV + SEG, U, IN(I_BREL), JT);
#endif
    GRID_BAR();
    {
        pg8::Gemm g{U, WOB, M, DM, DM}; pg8::StaticOrder S; S.init(M, DM, G, bx);
        pg8::EpiResid E{nullptr, U2, nullptr, U2, SSQ + (size_t)16 * M, (LAS float*)(L + XCH_OFF)};
        pg8::gemm_phase<pg8::EpiResid>(L, g, S, E);
    }
    GRID_BAR();
    MLP_BLOCK(1, SSQ + (size_t)16 * M, out, (GAS bf16_t*)nullptr, (GAS float*)nullptr);
#undef MLP_BLOCK
}

extern "C" void kernel_launch(void* const* d_in, const int* in_sizes, int n_in, void* d_out, int out_size, void* d_ws, size_t ws_size, hipStream_t stream) {
    static int grid = 0;
    if (grid == 0) {
        if (n_in != 18 || in_sizes[0] != M * DM || out_size != M * DM || ws_size < WS_END) {
            fprintf(stderr, "kernel_launch: shape mismatch (n_in %d in0 %d out %d ws %zu)\n", n_in, n_in > 0 ? in_sizes[0] : -1, out_size, ws_size); grid = -1; return; }
        int dev = 0, cus = 0, per_cu = 0;
        (void)hipGetDevice(&dev);
        if (hipDeviceGetAttribute(&cus, hipDeviceAttributeMultiprocessorCount, dev) != hipSuccess || cus <= 0) cus = 256;
        if (hipFuncSetAttribute((const void*)fwd_megakernel, hipFuncAttributeMaxDynamicSharedMemorySize, LDS_BYTES) != hipSuccess) { fprintf(stderr, "kernel_launch: hipFuncSetAttribute failed\n"); grid = -1; return; }
        if (hipOccupancyMaxActiveBlocksPerMultiprocessor(&per_cu, (const void*)fwd_megakernel, 512, LDS_BYTES) != hipSuccess || per_cu < 1) { fprintf(stderr, "kernel_launch: occupancy query says %d\n", per_cu); per_cu = 1; }
        (void)hipGetLastError();
        grid = cus * per_cu;
    }
    if (grid < 0) return;
    Args a{};
    for (int i = 0; i < 18; ++i) a.in[i] = (const float*)d_in[i];
    a.out = (float*)d_out; a.ws = (unsigned char*)d_ws;
    void* args[] = {&a};
    hipError_t e = hipLaunchCooperativeKernel((const void*)fwd_megakernel, dim3(grid), dim3(512), args, LDS_BYTES, stream);
    if (e != hipSuccess) fprintf(stderr, "kernel_launch: cooperative launch failed: %s (grid %d)\n", hipGetErrorString(e), grid);
}
```

```cpp
#include <hip/hip_runtime.h>
#include <hip/hip_cooperative_groups.h>
#include <cstdio>
#include <cstdint>
namespace cg = cooperative_groups;

#ifndef STAGGER_TICKS
#define STAGGER_TICKS 0
#endif
#ifndef PROBE_REPEAT
#define PROBE_REPEAT 0
#endif
#define LAS __attribute__((address_space(3)))
#define GAS __attribute__((address_space(1)))
typedef unsigned short bf16_t;
typedef short bf16x8 __attribute__((ext_vector_type(8)));
typedef short s16x4 __attribute__((ext_vector_type(4)));
typedef float f32x4 __attribute__((ext_vector_type(4)));
typedef float f32x16 __attribute__((ext_vector_type(16)));
typedef unsigned u32x4 __attribute__((ext_vector_type(4)));
typedef unsigned u32x2 __attribute__((ext_vector_type(2)));

constexpr int BATCH = 8, SEQ = 4096, DM = 2048, NH = 16, HD = 128, FF = 8192, NREL = 320;
constexpr int M = BATCH * SEQ;
constexpr int NIN_A = 3 * DM + 256;
constexpr int NIN_B = 3 * DM;
constexpr float EPS = 1e-6f;
constexpr float SCALE = 0.08838834764831845f;
constexpr float RSC = 11.313708498984761f;

constexpr size_t MiB = 1u << 20;
constexpr size_t WS_GT = 512 * 1024;
constexpr size_t WS_LF = 1 * MiB;
constexpr size_t WS_WIN = 4 * MiB;
constexpr size_t WS_WOA = 29 * MiB;
constexpr size_t WS_W1 = 37 * MiB;
constexpr size_t WS_W2 = 101 * MiB;
constexpr size_t WS_WKVQ = 165 * MiB;
constexpr size_t WS_WOB = 189 * MiB;
constexpr size_t WS_U = 200 * MiB;
constexpr size_t WS_QKV = 328 * MiB;
constexpr size_t SEG = (size_t)M * DM;
constexpr size_t WS_U2 = 840 * MiB;
constexpr size_t WS_SSQ = 968 * MiB;
constexpr size_t WS_END = 972 * MiB;

constexpr int RING_BYTES = 131072;
constexpr int XCH_OFF = RING_BYTES;
constexpr int BARW_OFF = XCH_OFF + 8192;
constexpr int LDS_BYTES = 147456;

__device__ __forceinline__ unsigned cvt_pk_bf16(float lo, float hi) { unsigned r; asm volatile("v_cvt_pk_bf16_f32 %0, %1, %2" : "=v"(r) : "v"(lo), "v"(hi)); return r; }
#define LDS_WAIT() asm volatile("s_waitcnt lgkmcnt(0)" ::: "memory")

namespace pg8 {
constexpr int BM = 256, BK = 64, HALF = 128, HTB = HALF * BK * 2, NXCD = 8, WGM = 8;
__host__ __device__ __forceinline__ int lds_byte(int r, int c) { const int st = (r >> 4) * 2 + (c >> 5), rr = r & 15, cc = c & 31, ob = rr * 64 + cc * 2; return st * 1024 + (ob ^ (((ob >> 9) & 1) << 5)); }
__host__ __device__ __forceinline__ void stage_rc(int b, int& R, int& C) { const int st = b / 1024, sb = b % 1024, swz = sb ^ (((sb >> 9) & 1) << 5); R = (st >> 1) * 16 + swz / 64; C = (st & 1) * 32 + (swz % 64) / 2; }
__host__ __device__ __forceinline__ int perm32(int rho) { const int n = rho >> 4, i = rho & 15; return 8 * (i >> 2) + 4 * n + (i & 3); }

struct Unit { int pm, pn; };
struct Gemm { const GAS bf16_t* A; const GAS bf16_t* Bt; int M, N, K; };

struct StaticOrder {
    int nM, nN, nwg, G, c;
    __device__ void init(int M_, int N_, int G_, int c_) { nM = M_ / BM; nN = N_ / BM; nwg = nM * nN; G = G_; c = c_; }
    __device__ bool next(int i, Unit& u) const {
        const long L = (long)i * G + c; if (L >= nwg) return false;
        int wgid = (int)L; { const int q = nwg / NXCD, r = nwg % NXCD, xcd = wgid % NXCD, off = wgid / NXCD; wgid = (xcd < r ? xcd * (q + 1) : r * (q + 1) + (xcd - r) * q) + off; }
        const int nig = WGM * nN, gid = wgid / nig, fm = gid * WGM, gsz = (nM - fm) < WGM ? (nM - fm) : WGM;
        u.pm = fm + ((wgid % nig) % gsz); u.pn = (wgid % nig) / gsz; return true;
    }
};


struct EpiQKV {
    static constexpr bool PERM = true;
    GAS bf16_t* O;
    const GAS float* gt; int normmask;
    GAS float* logf; const GAS float* bfg;
    const GAS float* ssq;
    LAS float* xch;
    __device__ __forceinline__ void operator()(const f32x4 (&acc)[2][2][4][2], const Unit& u, int wr, int wc, int fr, int fq) const {
        const int t = u.pn >> 3;
        const int row0 = u.pm * BM + wr * 64 + fr;
        if (t == 3) {
            if (wc == 0 && fq < 2) {
#pragma unroll
                for (int ai = 0; ai < 2; ++ai)
#pragma unroll
                    for (int m = 0; m < 4; ++m) { const int row = row0 + ai * HALF + m * 16; const int b = row >> 12, s = row & 4095;
                        float rw = 1.f;
                        if (ssq) { const GAS f32x4* pp = (const GAS f32x4*)(ssq + (size_t)row * 8); const f32x4 p = pp[0], q = pp[1];
                            rw = rsqrtf((((p[0] + p[1]) + (p[2] + p[3])) + ((q[0] + q[1]) + (q[2] + q[3]))) * (1.f / DM) + EPS); }
#pragma unroll
                        for (int n = 0; n < 2; ++n)
#pragma unroll
                            for (int j = 0; j < 4; ++j) { const int c = 8 * fq + 4 * n + j; const float z = acc[ai][0][m][n][j] * rw + bfg[c];
                                const float lf = fminf(z, 0.f) - __logf(1.f + __expf(-fabsf(z)));
                                logf[((size_t)(b * NH + c)) * SEQ + s] = lf; } }
            }
            return;
        }
        const GAS float* gp = gt + t * HD; const bool g = (normmask >> t) & 1;
        GAS bf16_t* base = O + (size_t)t * SEG;
        const int colt = (u.pn & 7) * BM + wc * 32 + 8 * fq;
        f32x4 gv0 = (f32x4){1.f, 1.f, 1.f, 1.f}, gv1 = gv0;
        float rw2a[2][4];
        if (ssq) {
#pragma unroll
            for (int ai = 0; ai < 2; ++ai)
#pragma unroll
                for (int m = 0; m < 4; ++m) { const GAS float* pp = ssq + (size_t)(row0 + ai * HALF + m * 16) * 8 + 2 * fq; rw2a[ai][m] = pp[0] + pp[1]; }
#pragma unroll
            for (int ai = 0; ai < 2; ++ai)
#pragma unroll
                for (int m = 0; m < 4; ++m) { float st = rw2a[ai][m]; st += __shfl_xor(st, 16); st += __shfl_xor(st, 32); rw2a[ai][m] = 1.f / (st * (1.f / DM) + EPS); } }
        if (g) {
#pragma unroll
            for (int ai = 0; ai < 2; ++ai)
#pragma unroll
                for (int m = 0; m < 4; ++m)
#pragma unroll
                    for (int bj = 0; bj < 2; ++bj) { const f32x4 a = acc[ai][bj][m][0], b = acc[ai][bj][m][1];
                        float s = (a[0] * a[0] + a[1] * a[1]) + (a[2] * a[2] + a[3] * a[3]) + (b[0] * b[0] + b[1] * b[1]) + (b[2] * b[2] + b[3] * b[3]);
                        s += __shfl_xor(s, 16); s += __shfl_xor(s, 32);
                        if (fq == 0) xch[((ai * HALF + wr * 64 + m * 16 + fr) * 2 + bj) * 4 + wc] = s; }
            LDS_WAIT(); __builtin_amdgcn_s_barrier(); asm volatile("" ::: "memory");
            int go = wc * 32 + 8 * fq; asm volatile("" : "+v"(go));
            gv0 = *(const GAS f32x4*)(gp + go); gv1 = *(const GAS f32x4*)(gp + go + 4);
        }
#pragma unroll
        for (int ai = 0; ai < 2; ++ai)
#pragma unroll
            for (int m = 0; m < 4; ++m) { GAS bf16_t* rowp = base + (size_t)(row0 + ai * HALF + m * 16) * DM + colt;
                float r0 = 1.f, r1 = 1.f, rw = 1.f, rw2 = 1.f;
                if (ssq) { rw2 = rw2a[ai][m]; rw = sqrtf(rw2); }
                if (g) { const LAS f32x4* pp = (const LAS f32x4*)(xch + ((ai * HALF + wr * 64 + m * 16 + fr) * 2) * 4); const f32x4 p = pp[0], q = pp[1];
                    r0 = rsqrtf(((p[0] + p[1]) + (p[2] + p[3])) * rw2 * (1.f / 128.f) + EPS); r1 = rsqrtf(((q[0] + q[1]) + (q[2] + q[3])) * rw2 * (1.f / 128.f) + EPS); }
                r0 *= rw; r1 *= rw;
#pragma unroll
                for (int bj = 0; bj < 2; ++bj) { const float rr = bj ? r1 : r0; const f32x4 v0 = acc[ai][bj][m][0] * rr * gv0, v1 = acc[ai][bj][m][1] * rr * gv1;
                    u32x4 w; w.x = cvt_pk_bf16(v0[0], v0[1]); w.y = cvt_pk_bf16(v0[2], v0[3]); w.z = cvt_pk_bf16(v1[0], v1[1]); w.w = cvt_pk_bf16(v1[2], v1[3]);
                    *(GAS u32x4*)(rowp + bj * HALF) = w; } }
    }
};
struct EpiResid {
    static constexpr bool PERM = false;
    const GAS float* xf; const GAS bf16_t* hin; GAS float* outf; GAS bf16_t* hb; GAS float* ssq;
    LAS float* xch;
    __device__ __forceinline__ void operator()(const f32x4 (&acc)[2][2][4][2], const Unit& u, int wr, int wc, int fr, int fq) const {
        const int row0 = u.pm * BM + wr * 64 + fr, col0 = u.pn * BM + wc * 32 + 4 * fq;
#pragma unroll
        for (int ai = 0; ai < 2; ++ai) {
            u32x2 hw[4][2][2];
            if (!xf) {
#pragma unroll
                for (int m = 0; m < 4; ++m)
#pragma unroll
                    for (int bj = 0; bj < 2; ++bj)
#pragma unroll
                        for (int n = 0; n < 2; ++n) hw[m][bj][n] = *(const GAS u32x2*)(hin + (size_t)(row0 + ai * HALF + m * 16) * DM + col0 + bj * HALF + n * 16);
            }
#pragma unroll
            for (int mh = 0; mh < 2; ++mh) {
                f32x4 xs[2][2][2];
                if (xf) {
#pragma unroll
                    for (int mm = 0; mm < 2; ++mm)
#pragma unroll
                        for (int bj = 0; bj < 2; ++bj)
#pragma unroll
                            for (int n = 0; n < 2; ++n) xs[mm][bj][n] = *(const GAS f32x4*)(xf + (size_t)(row0 + ai * HALF + (2 * mh + mm) * 16) * DM + col0 + bj * HALF + n * 16);
                }
#pragma unroll
                for (int mm = 0; mm < 2; ++mm) { const int m = 2 * mh + mm; const int row = row0 + ai * HALF + m * 16; const size_t off = (size_t)row * DM + col0;
                    float sq = 0.f;
#pragma unroll
                    for (int bj = 0; bj < 2; ++bj)
#pragma unroll
                        for (int n = 0; n < 2; ++n) { f32x4 b4;
                            if (xf) b4 = xs[mm][bj][n];
                            else { const u32x2 w = hw[m][bj][n]; b4 = (f32x4){__uint_as_float(w.x << 16), __uint_as_float(w.x & 0xffff0000u), __uint_as_float(w.y << 16), __uint_as_float(w.y & 0xffff0000u)}; }
                            const f32x4 v = acc[ai][bj][m][n] + b4;
                            if (outf) *(GAS f32x4*)(outf + off + bj * HALF + n * 16) = v;
                            if (hb) { u32x2 w; w.x = cvt_pk_bf16(v[0], v[1]); w.y = cvt_pk_bf16(v[2], v[3]); *(GAS u32x2*)(hb + off + bj * HALF + n * 16) = w;
                                sq += (v[0] * v[0] + v[1] * v[1]) + (v[2] * v[2] + v[3] * v[3]); } }
                    if (hb) { sq += __shfl_xor(sq, 16); sq += __shfl_xor(sq, 32); if (fq == 0) xch[(ai * HALF + wr * 64 + m * 16 + fr) * 4 + wc] = sq; }
                }
                if (xf) asm volatile("" ::: "memory");
            }
            asm volatile("" ::: "memory");
        }
        if (hb) { LDS_WAIT(); __builtin_amdgcn_s_barrier(); asm volatile("" ::: "memory");
            const int t = wr * 256 + wc * 64 + fq * 16 + fr;
            if (t < 256) { const f32x4 p = *(const LAS f32x4*)(xch + t * 4); ssq[(size_t)(u.pm * BM + t) * 8 + u.pn] = (p[0] + p[1]) + (p[2] + p[3]); } }
    }
};
struct EpiRelu2 {
    static constexpr bool PERM = true;
    GAS bf16_t* O; const GAS float* ssq;
    __device__ __forceinline__ void operator()(const f32x4 (&acc)[2][2][4][2], const Unit& u, int wr, int wc, int fr, int fq) const {
        const int row0 = u.pm * BM + wr * 64 + fr, col0 = u.pn * BM + wc * 32 + 8 * fq;
        float sp[2][4];
#pragma unroll
        for (int ai = 0; ai < 2; ++ai)
#pragma unroll
            for (int m = 0; m < 4; ++m) { const GAS float* pp = ssq + (size_t)(row0 + ai * HALF + m * 16) * 8 + 2 * fq; sp[ai][m] = pp[0] + pp[1]; }
#pragma unroll
        for (int ai = 0; ai < 2; ++ai)
#pragma unroll
            for (int m = 0; m < 4; ++m) { GAS bf16_t* rowp = O + (size_t)(row0 + ai * HALF + m * 16) * FF + col0;
                float st = sp[ai][m]; st += __shfl_xor(st, 16); st += __shfl_xor(st, 32);
                const float r2 = 1.f / (st * (1.f / DM) + EPS);
#pragma unroll
                for (int bj = 0; bj < 2; ++bj) { f32x4 v0 = acc[ai][bj][m][0], v1 = acc[ai][bj][m][1];
#pragma unroll
                    for (int j = 0; j < 4; ++j) { v0[j] = fmaxf(v0[j], 0.f); v1[j] = fmaxf(v1[j], 0.f); }
                    v0 = v0 * v0 * r2; v1 = v1 * v1 * r2;
                    u32x4 w; w.x = cvt_pk_bf16(v0[0], v0[1]); w.y = cvt_pk_bf16(v0[2], v0[3]); w.z = cvt_pk_bf16(v1[0], v1[1]); w.w = cvt_pk_bf16(v1[2], v1[3]);
                    *(GAS u32x4*)(rowp + bj * HALF) = w; } }
    }
};

template <class Epi>
__device__ __forceinline__ void gemm_phase(LAS unsigned char* lds, Gemm g, const StaticOrder& S, const Epi& E) {
    int tid = threadIdx.x; asm volatile("" : "+v"(tid));
    asm volatile("" : "+s"(g.A), "+s"(g.Bt));
    const int wid = __builtin_amdgcn_readfirstlane(tid >> 6), lane = tid & 63, wr = wid >> 2, wc = wid & 3, fr = lane & 15, fq = lane >> 4;
    const int K = g.K, nt = K / BK;
    unsigned voffA[2], voffB[2];
#pragma unroll
    for (int i = 0; i < 2; ++i) { int R, C; stage_rc(tid * 16 + i * 8192, R, C); const int Rb = Epi::PERM ? ((R & ~31) + perm32(R & 31)) : R;
        voffA[i] = (unsigned)(R * K + C) * 2u; voffB[i] = (unsigned)(Rb * K + C) * 2u; }
    const size_t kstep = (size_t)(BK * 2);
    const size_t hstep = (size_t)HALF * K * 2;
    const size_t tstep = 2 * hstep;
    const unsigned ldsw = (unsigned)wid * 1024u;
    const int aoff = lds_byte(wr * 64 + fr, fq * 8), boff = lds_byte(wc * 32 + fr, fq * 8);
#define PG8_SA(b, h) (((b) * 2 + (h)) * HTB)
#define PG8_SB(b, h) ((4 + (b) * 2 + (h)) * HTB)
#define PG8_STAGE(bufoff, gbase, voff) do { _Pragma("unroll") for (int _i = 0; _i < 2; ++_i) \
        __builtin_amdgcn_global_load_lds((const GAS unsigned*)((const GAS char*)(gbase) + (voff)[_i]), (LAS unsigned*)(lds + (bufoff) + ldsw + _i * 8192), 16, 0, 0); } while (0)
#define PG8_LDA(dst, b, h) do { _Pragma("unroll") for (int m = 0; m < 4; ++m) _Pragma("unroll") for (int k = 0; k < 2; ++k) dst[m][k] = *(const LAS bf16x8*)(lds + PG8_SA(b, h) + aoff + m * 2048 + k * 1024); } while (0)
#define PG8_LDB(dst, b, h) do { _Pragma("unroll") for (int n = 0; n < 2; ++n) _Pragma("unroll") for (int k = 0; k < 2; ++k) dst[n][k] = *(const LAS bf16x8*)(lds + PG8_SB(b, h) + boff + n * 2048 + k * 1024); } while (0)
#define PG8_MMA(ai, bj, At, Bt) do { __builtin_amdgcn_s_setprio(1); _Pragma("unroll") for (int m = 0; m < 4; ++m) _Pragma("unroll") for (int n = 0; n < 2; ++n) _Pragma("unroll") for (int k = 0; k < 2; ++k) \
        acc[ai][bj][m][n] = __builtin_amdgcn_mfma_f32_16x16x32_bf16(Bt[n][k], At[m][k], acc[ai][bj][m][n], 0, 0, 0); __builtin_amdgcn_s_setprio(0); } while (0)
#define PG8_WAIT_V(n) asm volatile("s_waitcnt vmcnt(" #n ")" ::: "memory")
#define PG8_WAIT_L(n) asm volatile("s_waitcnt lgkmcnt(" #n ")" ::: "memory")
#define PG8_BAR __builtin_amdgcn_s_barrier()
#define PG8_SCHED __builtin_amdgcn_sched_barrier(0)
    Unit cur, nxt; int ui = 0;
    if (!S.next(0, cur)) return;
    if (STAGGER_TICKS > 0 && (S.c & 1)) { const unsigned long long t0_ = __builtin_amdgcn_s_memrealtime(); while (__builtin_amdgcn_s_memrealtime() - t0_ < (unsigned long long)STAGGER_TICKS) __builtin_amdgcn_s_sleep(16); }
    f32x4 acc[2][2][4][2];
#pragma unroll
    for (int a = 0; a < 2; ++a)
#pragma unroll
        for (int b = 0; b < 2; ++b)
#pragma unroll
            for (int m = 0; m < 4; ++m)
#pragma unroll
                for (int n = 0; n < 2; ++n) acc[a][b][m][n] = (f32x4){0.f, 0.f, 0.f, 0.f};
    bf16x8 At[4][2], B0[2][2], B1[2][2];
    const GAS char* cA = (const GAS char*)g.A + (size_t)cur.pm * tstep; const GAS char* cB = (const GAS char*)g.Bt + (size_t)cur.pn * tstep;
    PG8_STAGE(PG8_SB(0, 0), cB, voffB); PG8_STAGE(PG8_SB(0, 1), cB + hstep, voffB); PG8_STAGE(PG8_SA(0, 0), cA, voffA); PG8_STAGE(PG8_SA(0, 1), cA + hstep, voffA);
    if (wr == 1) PG8_BAR;
    PG8_WAIT_V(2); PG8_BAR;
    PG8_STAGE(PG8_SB(1, 0), cB + kstep, voffB); PG8_STAGE(PG8_SA(1, 0), cA + kstep, voffA); PG8_STAGE(PG8_SB(1, 1), cB + hstep + kstep, voffB);
    PG8_WAIT_V(6); PG8_BAR;
    for (;;) {
        const bool has_next = S.next(ui + 1, nxt);
        const GAS char* nA = has_next ? (const GAS char*)g.A + (size_t)nxt.pm * tstep : cA; const GAS char* nB = has_next ? (const GAS char*)g.Bt + (size_t)nxt.pn * tstep : cB;
        for (int t = 0; t < nt; t += 2) {
            const bool last = (t == nt - 2);
            const GAS char* a1 = cA + (size_t)(t + 1) * kstep;
            const GAS char* a2 = last ? nA : cA + (size_t)(t + 2) * kstep; const GAS char* b2 = last ? nB : cB + (size_t)(t + 2) * kstep;
            const GAS char* a3 = a2 + kstep; const GAS char* b3 = b2 + kstep;
            PG8_LDB(B0, 0, 0); PG8_LDB(B1, 0, 1); PG8_SCHED; PG8_LDA(At, 0, 0); PG8_STAGE(PG8_SA(1, 1), a1 + hstep, voffA);
            PG8_WAIT_V(8); PG8_WAIT_L(0); PG8_BAR; PG8_MMA(0, 0, At, B0); PG8_MMA(0, 1, At, B1); PG8_BAR; PG8_SCHED;
            PG8_LDA(At, 0, 1); PG8_STAGE(PG8_SB(0, 0), b2, voffB); PG8_STAGE(PG8_SB(0, 1), b2 + hstep, voffB); PG8_STAGE(PG8_SA(0, 0), a2, voffA);
            PG8_WAIT_V(8); PG8_WAIT_L(0); PG8_BAR; PG8_MMA(1, 0, At, B0); PG8_MMA(1, 1, At, B1); PG8_BAR; PG8_SCHED;
            PG8_LDB(B0, 1, 0); PG8_LDB(B1, 1, 1); PG8_SCHED; PG8_LDA(At, 1, 0); PG8_STAGE(PG8_SA(0, 1), a2 + hstep, voffA);
            PG8_WAIT_V(8); PG8_WAIT_L(0); PG8_BAR; PG8_MMA(0, 0, At, B0); PG8_MMA(0, 1, At, B1); PG8_BAR; PG8_SCHED;
            PG8_LDA(At, 1, 1); PG8_STAGE(PG8_SB(1, 0), b3, voffB); PG8_STAGE(PG8_SB(1, 1), b3 + hstep, voffB); PG8_STAGE(PG8_SA(1, 0), a3, voffA);
            PG8_WAIT_V(8); PG8_WAIT_L(0); PG8_BAR; PG8_MMA(1, 0, At, B0); PG8_MMA(1, 1, At, B1); PG8_BAR; PG8_SCHED;
        }
        if (wr == 0) PG8_BAR;
        E(acc, cur, wr, wc, fr, fq);
        if (!has_next) break;
#pragma unroll
        for (int a = 0; a < 2; ++a)
#pragma unroll
            for (int b = 0; b < 2; ++b)
#pragma unroll
                for (int m = 0; m < 4; ++m)
#pragma unroll
                    for (int n = 0; n < 2; ++n) acc[a][b][m][n] = (f32x4){0.f, 0.f, 0.f, 0.f};
        cur = nxt; cA = nA; cB = nB; ++ui;
        if (wr == 1) PG8_BAR;
    }
    PG8_WAIT_V(0);
    PG8_BAR;
#undef PG8_SA
#undef PG8_SB
#undef PG8_STAGE
#undef PG8_LDA
#undef PG8_LDB
#undef PG8_MMA
#undef PG8_WAIT_V
#undef PG8_WAIT_L
#undef PG8_BAR
#undef PG8_SCHED
}
}

namespace att {
constexpr int D = 128, RS = 2048, NW = 8, QBLK = 32, KVBLK = 64, QB = NW * QBLK;
constexpr int SHM_V = KVBLK * D * 2, SHM_K = KVBLK * D * 2;
constexpr int OFF_WS = 2 * SHM_V + 2 * SHM_K;
constexpr int OFF_BIAS = OFF_WS + NW * 64 * 4;
constexpr int OFF_OST = 86016, OST_WAVE = 16 * 272;
constexpr int CST = 648;
constexpr float THR = 40.f;

#define KSWZ(row, colB) ((row) * 256 + ((colB) ^ (((row) & 7) << 4)))
#define SBAR() __builtin_amdgcn_sched_barrier(0)
__device__ __forceinline__ int v_st(int k, int c) { const int kk = (k & ~0xC) | ((k & 4) << 1) | ((k & 8) >> 1); return ((kk >> 3) * 4 + (c >> 5)) * 512 + ((kk & 7) * 32 + (c & 31)) * 2; }
__device__ __forceinline__ int v_rd_base(int lane) { return ((lane & 3) << 3) | (((lane >> 2) & 3) << 6) | (((lane >> 4) & 1) << 5) | (((lane >> 5) & 1) << 8); }
constexpr int v_rd_off(int d0, int ks, int half) { return d0 * 512 + ks * 4096 + half * 2048; }
__device__ __forceinline__ int crow(int r, int hi) { return (r & 3) + 8 * (r >> 2) + 4 * hi; }
__device__ __forceinline__ unsigned cvtpk(float lo, float hi) { unsigned r; asm volatile("v_cvt_pk_bf16_f32 %0, %1, %2" : "=v"(r) : "v"(lo), "v"(hi)); return r; }
__device__ __forceinline__ bf16x8 load8(const GAS bf16_t* p) { return *(const GAS bf16x8*)(p); }

__device__ __forceinline__ void mask_tile(f32x16& p0, f32x16& p1, int dq, unsigned W) {
    const float NEG = -__builtin_inff();
#pragma unroll
    for (int r = 0; r < 16; ++r) {
        const int c = (r & 3) + 8 * (r >> 2);
        if ((unsigned)(dq - c) >= W) p0[r] = NEG;
        if ((unsigned)(dq - c - 32) >= W) p1[r] = NEG;
    }
}
__device__ __forceinline__ void partialSM(f32x16& p0, f32x16& p1, float& m_reg, float& mn, float& alpha) {
    float pmax = p0[0];
#pragma unroll
    for (int r = 1; r < 16; ++r) pmax = fmaxf(pmax, p0[r]);
#pragma unroll
    for (int r = 0; r < 16; ++r) pmax = fmaxf(pmax, p1[r]);
    { auto rr = __builtin_amdgcn_permlane32_swap(__float_as_uint(pmax), __float_as_uint(pmax), false, false);
      pmax = fmaxf(__uint_as_float(rr[0]), __uint_as_float(rr[1])); }
    constexpr float C2 = 1.4426950408889634f * SCALE;
    if (__builtin_expect(__all((pmax - m_reg) * SCALE <= THR), 1)) { mn = m_reg; alpha = 1.f; }
    else { mn = fmaxf(m_reg, pmax); alpha = __builtin_amdgcn_exp2f((m_reg - mn) * C2); m_reg = mn; }
    const float mnL = -mn * C2;
#pragma unroll
    for (int r = 0; r < 16; ++r) p0[r] = fmaf(p0[r], C2, mnL);
#pragma unroll
    for (int r = 0; r < 16; ++r) p1[r] = fmaf(p1[r], C2, mnL);
#pragma unroll
    for (int r = 0; r < 16; ++r) p0[r] = __builtin_amdgcn_exp2f(p0[r]);
}
__device__ __forceinline__ void finishSM(f32x16& p0, f32x16& p1, float alpha, float& l_reg, bf16x8& pa0, bf16x8& pa1, bf16x8& pa2, bf16x8& pa3) {
#pragma unroll
    for (int r = 0; r < 16; ++r) p1[r] = __builtin_amdgcn_exp2f(p1[r]);
    float ps = 0;
#pragma unroll
    for (int r = 0; r < 16; ++r) ps += p0[r];
#pragma unroll
    for (int r = 0; r < 16; ++r) ps += p1[r];
    { auto rr = __builtin_amdgcn_permlane32_swap(__float_as_uint(ps), __float_as_uint(ps), false, false);
      ps = __uint_as_float(rr[0]) + __uint_as_float(rr[1]); }
    l_reg = l_reg * alpha + ps;
#define PK4(P, B_, OUT) do { unsigned a0 = cvtpk(P[B_+0], P[B_+1]), a1 = cvtpk(P[B_+2], P[B_+3]);                          \
        unsigned b0 = cvtpk(P[B_+4], P[B_+5]), b1 = cvtpk(P[B_+6], P[B_+7]);                                             \
        auto r0 = __builtin_amdgcn_permlane32_swap(a0, b0, false, false); auto r1 = __builtin_amdgcn_permlane32_swap(a1, b1, false, false); \
        u32x4 w = {r0[0], r1[0], r0[1], r1[1]}; OUT = *reinterpret_cast<bf16x8*>(&w); } while (0)
    PK4(p0, 0, pa0); PK4(p0, 8, pa1); PK4(p1, 0, pa2); PK4(p1, 8, pa3);
#undef PK4
}
template <int KB, bool SK>
__device__ __forceinline__ void qkt(f32x16& p0, f32x16& p1, const char* K_lds, int r32, int hi, const bf16x8* qr, bool act, const char* bp) {
    if (SK && !act) { const float NEG = -__builtin_inff();
#pragma unroll
        for (int r = 0; r < 16; ++r) { p0[r] = NEG; p1[r] = NEG; } return; }
    { const f32x4 b0 = *(const f32x4*)(bp), b1 = *(const f32x4*)(bp + 32), b2 = *(const f32x4*)(bp + 64), b3 = *(const f32x4*)(bp + 96);
      const f32x4 b4 = *(const f32x4*)(bp + 128), b5 = *(const f32x4*)(bp + 160), b6 = *(const f32x4*)(bp + 192), b7 = *(const f32x4*)(bp + 224);
      p0 = (f32x16){b0[0], b0[1], b0[2], b0[3], b1[0], b1[1], b1[2], b1[3], b2[0], b2[1], b2[2], b2[3], b3[0], b3[1], b3[2], b3[3]};
      p1 = (f32x16){b4[0], b4[1], b4[2], b4[3], b5[0], b5[1], b5[2], b5[3], b6[0], b6[1], b6[2], b6[3], b7[0], b7[1], b7[2], b7[3]}; }
    const char* kb[4];
#pragma unroll
    for (int dd = 0; dd < 4; ++dd) kb[dd] = K_lds + KB * SHM_K + KSWZ(r32, (dd * 16 + hi * 8) * 2);
#pragma unroll
    for (int d0 = 0; d0 < 8; ++d0) { const char* a = kb[d0 & 3] + (d0 >> 2) * 128;
        bf16x8 b0 = *reinterpret_cast<const bf16x8*>(a);
        bf16x8 b1 = *reinterpret_cast<const bf16x8*>(a + 32 * 256);
        p0 = __builtin_amdgcn_mfma_f32_32x32x16_bf16(b0, qr[d0], p0, 0, 0, 0);
        p1 = __builtin_amdgcn_mfma_f32_32x32x16_bf16(b1, qr[d0], p1, 0, 0, 0); }
}
template <int VB, bool SK>
__device__ __forceinline__ void pv_tile(f32x16* o, int vb0, bf16x8 pa0, bf16x8 pa1, bf16x8 pa2, bf16x8 pa3, bool act) {
    if (SK && !act) return;
#define TRRD(dst, off) asm volatile("ds_read_b64_tr_b16 %0, %1 offset:%2" : "=&v"(dst) : "v"(vb0), "i"(off) : "memory")
#define PV_D0(d0) do { s16x4 l0, l1, l2, l3, h0, h1, h2, h3; constexpr int b_ = VB * SHM_V + v_rd_off(d0, 0, 0); \
        TRRD(l0, b_); TRRD(h0, b_ + 2048); TRRD(l1, b_ + 4096); TRRD(h1, b_ + 6144); TRRD(l2, b_ + 8192); TRRD(h2, b_ + 10240); TRRD(l3, b_ + 12288); TRRD(h3, b_ + 14336); \
        asm volatile("s_waitcnt lgkmcnt(0)" ::: "memory"); SBAR();   \
        o[d0] = __builtin_amdgcn_mfma_f32_32x32x16_bf16(pa0, (bf16x8){l0[0], l0[1], l0[2], l0[3], h0[0], h0[1], h0[2], h0[3]}, o[d0], 0, 0, 0);   \
        o[d0] = __builtin_amdgcn_mfma_f32_32x32x16_bf16(pa1, (bf16x8){l1[0], l1[1], l1[2], l1[3], h1[0], h1[1], h1[2], h1[3]}, o[d0], 0, 0, 0);   \
        o[d0] = __builtin_amdgcn_mfma_f32_32x32x16_bf16(pa2, (bf16x8){l2[0], l2[1], l2[2], l2[3], h2[0], h2[1], h2[2], h2[3]}, o[d0], 0, 0, 0);   \
        o[d0] = __builtin_amdgcn_mfma_f32_32x32x16_bf16(pa3, (bf16x8){l3[0], l3[1], l3[2], l3[3], h3[0], h3[1], h3[2], h3[3]}, o[d0], 0, 0, 0); } while (0)
    PV_D0(0); PV_D0(1); PV_D0(2); PV_D0(3);
#undef PV_D0
#undef TRRD
}

struct BlockRef { const GAS bf16_t* Q; const GAS bf16_t* K; const GAS bf16_t* V; GAS bf16_t* O; const GAS float* bt; int P0; int jl; };
struct Seam { bf16x8 qr[8]; bf16x8 st_v0, st_v1, st_k0, st_k1; };

#define ROW(p, k0, rr) ((p) + (size_t)((k0) + (rr)) * RS + sc)
#define VMW() asm volatile("s_waitcnt vmcnt(0)" ::: "memory")
#define VMWN(n) asm volatile("s_waitcnt vmcnt(%0)" :: "i"(n) : "memory")
#define SLOAD_H(Kp, Vp, k0) do { S.st_v0 = load8(ROW(Vp, k0, sr)); S.st_v1 = load8(ROW(Vp, k0, 32 + sr));              \
                         S.st_k0 = load8(ROW(Kp, k0, sr)); S.st_k1 = load8(ROW(Kp, k0, 32 + sr)); } while (0)
#define SWRITE_HK(bf) do { *(bf16x8*)(K_lds + (bf) * SHM_K + kws) = S.st_k0; *(bf16x8*)(K_lds + (bf) * SHM_K + kws + 32 * 256) = S.st_k1; } while (0)
#define SWRITE_HV(bf) do { *(bf16x8*)(V_lds + (bf) * SHM_V + vst0) = S.st_v0; *(bf16x8*)(V_lds + (bf) * SHM_V + vst1) = S.st_v1; } while (0)
#define SWRITE_H(bf) do { SWRITE_HV(bf); SWRITE_HK(bf); } while (0)

template <int MODE>
__device__ __forceinline__ void attn_prime(const BlockRef& cur, char* lds, Seam& S) {
    int tid = threadIdx.x; asm volatile("" : "+v"(tid));
    const int wid = __builtin_amdgcn_readfirstlane(tid >> 6), lane = tid & 63, r32 = lane & 31, hi = lane >> 5;
    const int sr = tid >> 4, sc = (tid & 15) * 8, kws = KSWZ(sr, sc * 2); char* K_lds = lds + 2 * SHM_V;
    const int kb0 = cur.jl * KVBLK;
#pragma unroll
    for (int d0 = 0; d0 < 8; ++d0) S.qr[d0] = load8(cur.Q + (size_t)(wid * QBLK + r32) * RS + d0 * 16 + hi * 8);
    SLOAD_H(cur.K, cur.V, kb0); VMW(); SWRITE_HK(0);
    __syncthreads();
}
template <int MODE>
__device__ __forceinline__ void attn_block(const BlockRef& cur, const BlockRef& nxt, char* lds, Seam& S, const bool newtab) {
    constexpr bool SK = (MODE == 1);
    int tid = threadIdx.x; asm volatile("" : "+v"(tid));
    const int wid = __builtin_amdgcn_readfirstlane(tid >> 6), lane = tid & 63, r32 = lane & 31, hi = lane >> 5;
    const int j_lo = cur.jl;
    const int j_hi = (cur.P0 >> 6) + 4;
    const int NT = j_hi - j_lo;
    const int kbn = nxt.jl * KVBLK;
    const int qlo = cur.P0 + wid * QBLK, qm = qlo + r32 - 4 * hi;
    const int cw = (cur.P0 >> 6) + (wid >> 1);
    char* V_lds = lds; char* K_lds = lds + 2 * SHM_V;
    float* ws = (float*)(lds + OFF_WS) + wid * 64; float* li_l = ws, * al_l = ws + 32;
    if (newtab) { float* tab = (float*)(lds + OFF_BIAS);
      if (MODE == 0) {
          _Pragma("clang loop vectorize(disable) unroll(disable)") for (int i = j_lo * KVBLK + tid; i < cur.P0 + QB; i += NW * 64) tab[i] = -cur.bt[i] * RSC; }
      else { _Pragma("clang loop vectorize(disable) unroll(disable)") for (int i = tid; i < 4 * CST; i += NW * 64) { const int a = i / CST, j = i - a * CST + a; int dist = 575 - j; dist = dist < -63 ? -63 : (dist > 256 ? 256 : dist);
                 tab[i] = cur.bt[dist + 63] * RSC; } }
      __syncthreads(); }
    int bl;
    if (MODE == 0) bl = OFF_BIAS + 16 * hi;
    else { const int tpos = cur.P0 + wid * QBLK + r32; const int a = (575 - tpos) & 3; bl = OFF_BIAS + a * (CST * 4) + 4 * (575 - tpos - a + 4 * hi); }
    asm volatile("" : "+v"(bl));
    float m_reg = -1e30f, l_reg = 0; f32x16 o[4] = {};
    if (wid >= 4) __builtin_amdgcn_s_setprio(1);
    const int sr = tid >> 4, sc = (tid & 15) * 8, vst0 = v_st(sr, sc), vst1 = v_st(32 + sr, sc), kws = KSWZ(sr, sc * 2);
    const int vb0 = (int)(uintptr_t)V_lds + v_rd_base(lane);
    const GAS bf16_t* Kh = cur.K; const GAS bf16_t* Vh = cur.V;
#define RESC(a) do { if (__any((a) < 1.f)) { if (hi == 0) al_l[r32] = (a); asm volatile("s_waitcnt lgkmcnt(0)" ::: "memory");              \
                     for (int d_ = 0; d_ < 4; ++d_) for (int r = 0; r < 16; ++r) o[d_][r] *= al_l[crow(r, hi)]; } } while (0)
#define KBASE(t) ((j_lo + (t)) * KVBLK)
#define BP(t) (lds + (bl + ((MODE == 0 || ACT(t)) ? KBASE(t) : cw * KVBLK) * 4))
#define ACT(t) (MODE == 0 ? true : ((j_lo + (t)) <= cw && (j_lo + (t)) >= cw - 8))
#define MASKT(P0_, P1_, t) do { if (MODE == 0) { const int kb_ = KBASE(t); if (kb_ + KVBLK - 1 > qlo) mask_tile(P0_, P1_, qm - kb_, 0x7fffffffu); } \
        else if (!ACT(t)) { const float NEG_ = -__builtin_inff(); _Pragma("unroll") for (int r_ = 0; r_ < 16; ++r_) { P0_[r_] = NEG_; P1_[r_] = NEG_; } } } while (0)
    constexpr int NQL = 8;
#define PSM(P0_, P1_, mn_, al_, t_) do { if (MODE == 1 && !ACT(t_)) { al_ = 1.f; } else partialSM(P0_, P1_, m_reg, mn_, al_); } while (0)
#define FSM(P0_, P1_, al_, t_) do { if (!(MODE == 1 && !ACT(t_))) finishSM(P0_, P1_, al_, l_reg, pa0, pa1, pa2, pa3); } while (0)
#define SEAM_K0() do { VMWN(NQL); SWRITE_HK(0); SBAR(); } while (0)
    f32x16 pA0, pA1, pB0, pB1; float mnA, mnB, alA, alB; bf16x8 pa0, pa1, pa2, pa3;
    SWRITE_HV(0); SBAR();
    if (NT > 1) { SLOAD_H(Kh, Vh, KBASE(1)); }
    SBAR(); qkt<0, SK>(pA0, pA1, K_lds, r32, hi, S.qr, ACT(0), BP(0));
    MASKT(pA0, pA1, 0); PSM(pA0, pA1, mnA, alA, 0);
    if (NT > 1) { VMW(); SWRITE_H(1); }
    __syncthreads();
#define HALF_STEP(PX0, PX1, mnX, alX, PY0, PY1, alY, t, KB, VB, SB) do {                                                      \
        SBAR(); qkt<KB, SK>(PX0, PX1, K_lds, r32, hi, S.qr, ACT(t), BP(t));                                      \
        FSM(PY0, PY1, alY, (t) - 1); SBAR();                                                                                  \
        if ((t) + 1 < NT) { SLOAD_H(Kh, Vh, KBASE((t) + 1)); SBAR(); }                                                        \
        pv_tile<VB, SK>(o, vb0, pa0, pa1, pa2, pa3, ACT((t) - 1)); MASKT(PX0, PX1, (t)); PSM(PX0, PX1, mnX, alX, (t));          \
        __syncthreads();                                                                                                      \
        if ((t) + 1 < NT) { VMW(); SWRITE_H(SB); }                                                                            \
        RESC(alX); __syncthreads(); } while (0)
    for (int t = 1; t + 1 < NT; t += 2) {
        HALF_STEP(pB0, pB1, mnB, alB, pA0, pA1, alA, t, 1, 0, 0);
        HALF_STEP(pA0, pA1, mnA, alA, pB0, pB1, alB, t + 1, 0, 1, 1);
    }
    const bool even = (NT & 1) == 0;
    if (even) { SBAR(); qkt<1, SK>(pB0, pB1, K_lds, r32, hi, S.qr, ACT(NT - 1), BP(NT - 1)); SBAR(); }
    SLOAD_H(nxt.K, nxt.V, kbn); SBAR();
#pragma unroll
    for (int d0 = 0; d0 < 8; ++d0) S.qr[d0] = load8(nxt.Q + (size_t)(wid * QBLK + r32) * RS + d0 * 16 + hi * 8);
    SBAR();
    FSM(pA0, pA1, alA, (even ? NT - 2 : NT - 1)); SBAR();
    pv_tile<0, SK>(o, vb0, pa0, pa1, pa2, pa3, ACT(even ? NT - 2 : NT - 1));
    if (even) { MASKT(pB0, pB1, NT - 1); PSM(pB0, pB1, mnB, alB, NT - 1); __syncthreads(); RESC(alB);
        FSM(pB0, pB1, alB, NT - 1); SBAR(); pv_tile<1, SK>(o, vb0, pa0, pa1, pa2, pa3, ACT(NT - 1)); }
    SBAR(); SEAM_K0();
    if (hi == 0) li_l[r32] = l_reg; asm volatile("s_waitcnt lgkmcnt(0)" ::: "memory");
    float rli[16];
#pragma unroll
    for (int r = 0; r < 16; ++r) rli[r] = __builtin_amdgcn_rcpf(li_l[crow(r, hi)]);
    GAS bf16_t* Ow = cur.O + (size_t)(wid * QBLK) * RS;
    char* ost = lds + OFF_OST + wid * OST_WAVE;
#pragma unroll
    for (int p = 0; p < 2; ++p) {
#pragma unroll
        for (int rr = 0; rr < 8; ++rr) { const int r = 8 * p + rr; const int lrow = crow(r, hi) - 16 * p;
#pragma unroll
            for (int d0 = 0; d0 < 4; ++d0) { const float v = o[d0][r] * rli[r]; const unsigned w = cvtpk(v, v);
                *(unsigned short*)(ost + lrow * 272 + (d0 * 32 + r32) * 2) = (unsigned short)w; } }
        asm volatile("s_waitcnt lgkmcnt(0)" ::: "memory");
#pragma unroll
        for (int k = 0; k < 4; ++k) { const int row = (lane >> 4) + 4 * k; const u32x4 w = *(const u32x4*)(ost + row * 272 + (lane & 15) * 16);
            *(GAS u32x4*)(Ow + (size_t)(16 * p + row) * RS + (lane & 15) * 8) = w; }
        asm volatile("s_waitcnt lgkmcnt(0)" ::: "memory");
    }
    if (wid >= 4) __builtin_amdgcn_s_setprio(0);
    __syncthreads();
#undef RESC
#undef KBASE
#undef BP
#undef ACT
#undef MASKT
#undef SEAM_K0
#undef PSM
#undef FSM
#undef HALF_STEP
}
#undef ROW
#undef VMW
#undef VMWN
#undef SLOAD_H
#undef SWRITE_HK
#undef SWRITE_HV
#undef SWRITE_H

template <int MODE>
__device__ __forceinline__ BlockRef block_ref(int n, int vcu, int G, const GAS bf16_t* Q, const GAS bf16_t* K, const GAS bf16_t* V, GAS bf16_t* O, const GAS float* bt, const GAS int* jtab) {
    int bh, qb;
    if (MODE == 0) {
        if (G == 2 * BATCH * NH) { bh = vcu >> 1; const int p = n >> 1; qb = (vcu & 1) ? ((n & 1) ? 13 - 4 * p : 14 - 4 * p) : ((n & 1) ? 12 - 4 * p : 15 - 4 * p); }
        else { const int L = vcu + n * G; bh = L >> 4; qb = 15 - (L & 15); }
    } else {
        if (G == 2 * BATCH * NH) { bh = vcu >> 1; qb = (vcu & 1) ? (n == 0 ? 1 : n + 8) : (n == 0 ? 0 : n + 1); }
        else { const int L = vcu + n * G; bh = L >> 4; qb = L & 15; }
    }
    const int b = bh >> 4, h = bh & 15;
    BlockRef r; const size_t row0 = (size_t)b * SEQ;
    r.Q = Q + (row0 + (size_t)qb * QB) * RS + h * D; r.O = O + (row0 + (size_t)qb * QB) * RS + h * D;
    r.K = K + row0 * RS + h * D; r.V = V + row0 * RS + h * D; r.P0 = qb * QB;
    r.bt = MODE == 0 ? bt + (size_t)bh * SEQ : bt + h * NREL;
    if (MODE == 0) r.jl = jtab[bh * 16 + qb]; else { const int j = (r.P0 >> 6) - 8; r.jl = j > 0 ? j : 0; }
    return r;
}
template <int MODE>
__device__ __forceinline__ void attn_phase(char* lds, int vcu, int G, const GAS bf16_t* Q, const GAS bf16_t* K, const GAS bf16_t* V, GAS bf16_t* O, const GAS float* bt, const GAS int* jtab) {
    asm volatile("" : "+s"(Q), "+s"(K), "+s"(V), "+s"(O), "+s"(bt), "+s"(vcu), "+s"(jtab), "+s"(G));
    const int total = BATCH * NH * 16;
    int nblk = 0; for (int L = vcu; L < total; L += G) ++nblk;
    if (nblk == 0) return;
    BlockRef cur = block_ref<MODE>(0, vcu, G, Q, K, V, O, bt, jtab);
    Seam S;
    attn_prime<MODE>(cur, lds, S);
    const GAS float* prev_bt = nullptr;
    for (int n = 0; n < nblk; ++n) {
        const bool last = (n + 1 == nblk);
        const BlockRef nxt = last ? cur : block_ref<MODE>(n + 1, vcu, G, Q, K, V, O, bt, jtab);
        attn_block<MODE>(cur, nxt, lds, S, cur.bt != prev_bt);
        prev_bt = cur.bt; cur = nxt;
    }
}
__device__ __forceinline__ BlockRef ticket_ref(int ticket, const GAS bf16_t* Q, const GAS bf16_t* K, const GAS bf16_t* V, GAS bf16_t* O, const GAS float* bt, const GAS int* jtab) {
    const int q = ticket >> 8, i = ticket & 255, qb = 15 - (i >> 4), bh = q * 16 + (i & 15);
    const int b = bh >> 4, h = bh & 15;
    BlockRef r; const size_t row0 = (size_t)b * SEQ;
    r.Q = Q + (row0 + (size_t)qb * QB) * RS + h * D; r.O = O + (row0 + (size_t)qb * QB) * RS + h * D;
    r.K = K + row0 * RS + h * D; r.V = V + row0 * RS + h * D; r.P0 = qb * QB;
    r.bt = bt + (size_t)bh * SEQ; r.jl = jtab[bh * 16 + qb];
    return r;
}
__device__ __forceinline__ void attn_phase_dyn(char* lds, GAS unsigned* qc  , const GAS bf16_t* Q, const GAS bf16_t* K, const GAS bf16_t* V, GAS bf16_t* O, const GAS float* bt, const GAS int* jtab) {
    asm volatile("" : "+s"(Q), "+s"(K), "+s"(V), "+s"(O), "+s"(bt), "+s"(jtab), "+s"(qc));
    volatile LAS int* tk = (volatile LAS int*)(LAS char*)(lds + OFF_BIAS + 16384 + 64);
    const unsigned xq = (unsigned)__builtin_amdgcn_s_getreg((3 << 11) | 20) & 7u;
    int slot = 0; if (threadIdx.x == 0) tk[2] = 0;
#define TK_PULL(out) do { if (threadIdx.x == 0) { unsigned t_ = 256u, kq = (unsigned)tk[2]; for (;;) { t_ = __hip_atomic_fetch_add(qc + 64 * ((xq + kq) & 7u), 1u, __ATOMIC_RELAXED, __HIP_MEMORY_SCOPE_AGENT); if (t_ < 256u || kq >= 7u) break; ++kq; } \
            tk[2] = (int)kq; tk[slot] = (t_ < 256u) ? (int)((((xq + kq) & 7u) << 8) | t_) : -1; } \
        __syncthreads(); out = __builtin_amdgcn_readfirstlane(tk[slot]); slot ^= 1; } while (0)
    int tc, tn;
    TK_PULL(tc); if (tc < 0) return;
    TK_PULL(tn);
    BlockRef cur = ticket_ref(tc, Q, K, V, O, bt, jtab);
    Seam S;
    attn_prime<0>(cur, lds, S);
    for (;;) {
        const bool last = tn < 0;
        const BlockRef nxt = last ? cur : ticket_ref(tn, Q, K, V, O, bt, jtab);
        attn_block<0>(cur, nxt, lds, S, true);
        if (last) break;
        cur = nxt; TK_PULL(tn);
    }
#undef TK_PULL
}
}


#define XB_TMO      128
#define XB_XCNT(j)  (256  + 64 * (j))
#define XB_XSUB(j)  (1280 + 64 * (j))
#define XB_XGEN(j)  (2304 + 64 * (j))
#define XB_TOP      3328
#define XB_TOPGEN   3392
#define XCD_BAR_WORDS 3456
#define XB_SPIN_CAP (1u << 18)
__device__ __forceinline__ unsigned xb_ld(unsigned* p)              { return __hip_atomic_load(p, __ATOMIC_RELAXED, __HIP_MEMORY_SCOPE_AGENT); }
__device__ __forceinline__ unsigned xb_add(unsigned* p, unsigned v) { return __hip_atomic_fetch_add(p, v, __ATOMIC_RELAXED, __HIP_MEMORY_SCOPE_AGENT); }
__device__ __forceinline__ unsigned xb_xcc_id() { return (unsigned)__builtin_amdgcn_s_getreg((3 << 11) | 20) & 0xFu; }
#define XB_SPIN(cond, bar) do { unsigned _sp = 0; while (cond) { __builtin_amdgcn_s_sleep(1); \
    if ((++_sp & 255u) == 0u) { if (xb_ld(&(bar)[XB_TMO])) break; if (_sp > XB_SPIN_CAP) { atomicAdd(&(bar)[XB_TMO], 1u); break; } } } } while (0)
struct XcdBarrier { unsigned* bar; unsigned x; volatile LAS unsigned* st; };
__device__ __forceinline__ XcdBarrier xcd_barrier_post(unsigned* bar, volatile LAS unsigned* st) {
    XcdBarrier b; b.bar = bar; b.x = xb_xcc_id(); b.st = st;
    if (threadIdx.x == 0) (void)xb_add(&bar[XB_XCNT(b.x)], 1u);
    return b;
}
__device__ __forceinline__ void xcd_barrier_complete(unsigned* bar, unsigned x, unsigned& nloc, unsigned& nx) {
    const unsigned G = gridDim.x * gridDim.y * gridDim.z;
    unsigned sum, cnt, mine, sp = 0u;
    for (;;) {
        sum = 0u; cnt = 0u; mine = 0u;
#pragma unroll
        for (unsigned j = 0; j < 16; ++j) { const unsigned c = xb_ld(&bar[XB_XCNT(j)]); sum += c; cnt += (c > 0u) ? 1u : 0u; mine = (j == x) ? c : mine; }
        if (sum == G) break;
        __builtin_amdgcn_s_sleep(1);
        if ((++sp & 255u) == 0u) { if (xb_ld(&bar[XB_TMO])) break; if (sp > XB_SPIN_CAP) { atomicAdd(&bar[XB_TMO], 1u); break; } }
    }
    nloc = mine > 0u ? mine : 1u; nx = cnt > 0u ? cnt : 1u;
}
__device__ __forceinline__ void xcd_barrier(const XcdBarrier& b) {
    asm volatile("s_waitcnt vmcnt(0)" ::: "memory");
    __syncthreads();
    if (threadIdx.x == 0) {
        unsigned* bar = b.bar;
        __builtin_amdgcn_s_waitcnt(0);
        unsigned nloc = b.st[0], nx = b.st[1];
        if (nloc == 0u) { xcd_barrier_complete(bar, b.x, nloc, nx); b.st[0] = nloc; b.st[1] = nx; }
        const unsigned old = xb_add(&bar[XB_XSUB(b.x)], 1u);
        const unsigned gen = old / nloc;
        if (old + 1u == (gen + 1u) * nloc) {
            __builtin_amdgcn_fence(__ATOMIC_RELEASE, "agent");
            asm volatile("s_waitcnt vmcnt(0)" ::: "memory");
            const unsigned og = xb_add(&bar[XB_TOP], 1u);
            const unsigned tg = og / nx;
            if (og + 1u == (tg + 1u) * nx) xb_add(&bar[XB_TOPGEN], 1u);
            else XB_SPIN(xb_ld(&bar[XB_TOPGEN]) == tg, bar);
            __builtin_amdgcn_fence(__ATOMIC_ACQUIRE, "agent");
            xb_add(&bar[XB_XGEN(b.x)], 1u);
            asm volatile("s_waitcnt vmcnt(0)" ::: "memory");
        } else {
            XB_SPIN(xb_ld(&bar[XB_XGEN(b.x)]) == gen, bar);
            __builtin_amdgcn_fence(__ATOMIC_ACQUIRE, "agent");
            asm volatile("s_waitcnt vmcnt(0)" ::: "memory");
        }
    }
    __syncthreads();
}

__device__ __forceinline__ float wave_sum(float v) {
#pragma unroll
    for (int o = 1; o < 64; o <<= 1) v += __shfl_xor(v, o);
    return v;
}
__device__ __forceinline__ unsigned f2bf(float f) { unsigned u = __builtin_bit_cast(unsigned, f); return (u + 0x7fffu + ((u >> 16) & 1u)) >> 16; }
__device__ __forceinline__ unsigned pk2(float lo, float hi) { return f2bf(lo) | (f2bf(hi) << 16); }
__device__ __forceinline__ void transpose_item(const GAS float* W, int K, int N, int ldn, const GAS float* gk, GAS bf16_t* WT, int row_off, LAS float* scr, int item, int nblk, int lane) {
    const int kb = item / nblk, nb = item - kb * nblk, k0 = 64 * kb, n0 = 32 * nb;
    const int n = n0 + (lane & 31);
    float wv[32];
#pragma unroll
    for (int i = 0; i < 32; ++i) wv[i] = 0.f;
    if (n0 + 32 <= N) {
#pragma unroll
        for (int i = 0; i < 32; ++i) { const int kk = 2 * i + (lane >> 5); wv[i] = __builtin_nontemporal_load(W + (size_t)(k0 + kk) * ldn + n); }
    } else if (n0 < N) {
#pragma unroll
        for (int i = 0; i < 32; ++i) { const int kk = 2 * i + (lane >> 5); if (n < N) wv[i] = __builtin_nontemporal_load(W + (size_t)(k0 + kk) * ldn + n); }
    }
#pragma unroll
    for (int i = 0; i < 32; ++i) { const int kk = 2 * i + (lane >> 5); scr[kk * 33 + (lane & 31)] = wv[i]; }
    const int c = lane & 7;
    f32x4 g0 = (f32x4){1.f, 1.f, 1.f, 1.f}, g1 = g0;
    if (gk) { g0 = *(const GAS f32x4*)(gk + k0 + 8 * c); g1 = *(const GAS f32x4*)(gk + k0 + 8 * c + 4); }
    LDS_WAIT(); asm volatile("" ::: "memory");
#pragma unroll
    for (int j = 0; j < 4; ++j) { const int nn = (lane >> 3) + 8 * j; const LAS float* s = scr + (8 * c) * 33 + nn;
        u32x4 o; o.x = pk2(s[0 * 33] * g0[0], s[1 * 33] * g0[1]); o.y = pk2(s[2 * 33] * g0[2], s[3 * 33] * g0[3]); o.z = pk2(s[4 * 33] * g1[0], s[5 * 33] * g1[1]); o.w = pk2(s[6 * 33] * g1[2], s[7 * 33] * g1[3]);
        *(GAS u32x4*)(WT + (size_t)(row_off + n0 + nn) * K + k0 + 8 * c) = o; }
    LDS_WAIT(); asm volatile("" ::: "memory");
}
__device__ __forceinline__ void seed_row(const GAS float* xrow, GAS bf16_t* orow, GAS float* ssq8, int lane) {
    asm volatile("" : "+v"(lane));
    const GAS f32x4* xr = (const GAS f32x4*)xrow + lane;
    f32x4 v[8]; float s = 0.f;
#pragma unroll
    for (int j = 0; j < 8; ++j) { v[j] = xr[64 * j]; s += (v[j][0] * v[j][0] + v[j][1] * v[j][1]) + (v[j][2] * v[j][2] + v[j][3] * v[j][3]); }
    GAS u32x2* o8 = (GAS u32x2*)orow + lane;
#pragma unroll
    for (int j = 0; j < 8; ++j) { u32x2 w; w.x = pk2(v[j][0], v[j][1]); w.y = pk2(v[j][2], v[j][3]); o8[64 * j] = w; }
    s = wave_sum(s);
    if (lane < 8) ssq8[lane] = lane == 0 ? s : 0.f;
}

struct Args { const float* in[18]; float* out; unsigned char* ws; };
enum { I_X = 0, I_ANG, I_AWIN, I_ABF, I_AQG, I_AKG, I_AWOUT, I_MNG, I_W1, I_W2, I_KVNG, I_KVW, I_KVKG, I_BNG, I_BWQ, I_BQG, I_BREL, I_BWOUT };

__global__ void __launch_bounds__(512, 2) fwd_megakernel(Args a) {
    extern __shared__ __attribute__((aligned(16))) unsigned char lds[];
    cg::grid_group grid = cg::this_grid();
    LAS unsigned char* L = (LAS unsigned char*)lds;
    const int wave = __builtin_amdgcn_readfirstlane(threadIdx.x >> 6);
    const int G = gridDim.x, bx = blockIdx.x;
    const int vcu = (G % 8 == 0) ? (bx % 8) * (G / 8) + bx / 8 : bx;
    GAS unsigned char* ws = (GAS unsigned char*)a.ws;
    GAS float* LF = (GAS float*)(ws + WS_LF); GAS float* GT = (GAS float*)(ws + WS_GT); GAS int* JT = (GAS int*)(ws + WS_GT + 8192);
    GAS bf16_t* WIN = (GAS bf16_t*)(ws + WS_WIN); GAS bf16_t* WOA = (GAS bf16_t*)(ws + WS_WOA); GAS bf16_t* W1T = (GAS bf16_t*)(ws + WS_W1); GAS bf16_t* W2T = (GAS bf16_t*)(ws + WS_W2);
    GAS bf16_t* WKVQ = (GAS bf16_t*)(ws + WS_WKVQ); GAS bf16_t* WOB = (GAS bf16_t*)(ws + WS_WOB);
    GAS bf16_t* U2 = (GAS bf16_t*)(ws + WS_U2); GAS float* SSQ = (GAS float*)(ws + WS_SSQ);
    GAS bf16_t* U = (GAS bf16_t*)(ws + WS_U); GAS bf16_t* QKV = (GAS bf16_t*)(ws + WS_QKV); GAS bf16_t* HID = QKV;
    GAS float* out = (GAS float*)a.out;
#define IN(i) ((const GAS float*)a.in[i])
    const int gw = vcu * 8 + wave, NGW = G * 8;
    if (threadIdx.x < 4) ((LAS unsigned*)(L + BARW_OFF))[threadIdx.x] = 0u;
    __syncthreads();
    if (bx == 0) for (int i = threadIdx.x; i < 4096; i += 512) ((GAS unsigned*)a.ws)[i] = 0u;
#define GRID_BAR() xcd_barrier(xbar)

    constexpr int I0 = 32 * 200, I1 = 32 * 64, I2 = 32 * 256, I3 = 128 * 64, I4 = 32 * 128, I5 = 32 * 64, I6 = 32 * 64;
    constexpr int NP0 = I0 + I1 + 2 * I2 + I3 + I4 + I5, NDEF = I3 + I6;
    for (int rep_ = 0; rep_ < (PROBE_REPEAT == 1 ? 2 : 1); ++rep_) {
        int tid = threadIdx.x; asm volatile("" : "+v"(tid)); const int lane = tid & 63;
        LAS float* scr = (LAS float*)(L + wave * 16384);
        for (int it = gw; it < NP0; it += NGW) {
            int r = it;
            if (r < I0) { transpose_item(IN(I_AWIN), DM, 3 * DM + NH, 3 * DM + NH, IN(I_ANG), WIN, 0, scr, r, 200, lane); continue; } r -= I0;
            if (r < I1) { transpose_item(IN(I_AWOUT), DM, DM, DM, nullptr, WOA, 0, scr, r, 64, lane); continue; } r -= I1;
            if (r < I2) { transpose_item(IN(I_W1), DM, FF, FF, IN(I_MNG), W1T, 0, scr, r, 256, lane); continue; } r -= I2;
            if (r < I2) { transpose_item(IN(I_W1) + (size_t)DM * FF, DM, FF, FF, IN(I_MNG) + DM, W1T + (size_t)FF * DM, 0, scr, r, 256, lane); continue; } r -= I2;
            if (r < I3) { transpose_item(IN(I_W2), FF, DM, DM, nullptr, W2T, 0, scr, r, 64, lane); continue; } r -= I3;
            if (r < I4) { transpose_item(IN(I_KVW), DM, 2 * DM, 2 * DM, IN(I_KVNG), WKVQ, 0, scr, r, 128, lane); continue; } r -= I4;
            transpose_item(IN(I_BWQ), DM, DM, DM, IN(I_BNG), WKVQ, 2 * DM, scr, r, 64, lane);
        }
        for (int m = gw; m < M; m += NGW) seed_row(IN(I_X) + (size_t)m * DM, U2 + (size_t)m * DM, SSQ + (size_t)24 * M + (size_t)m * 8, lane);
        if (bx == 0 && tid < HD) { GT[tid] = IN(I_AQG)[tid]; GT[HD + tid] = IN(I_AKG)[tid]; GT[2 * HD + tid] = 1.f;
            GT[3 * HD + tid] = IN(I_KVKG)[tid]; GT[4 * HD + tid] = 1.f; GT[5 * HD + tid] = IN(I_BQG)[tid]; }
    }
    grid.sync();
    const XcdBarrier xbar = xcd_barrier_post((unsigned*)a.ws, (volatile LAS unsigned*)(L + BARW_OFF));

    {
        pg8::Gemm g{U2, WIN, M, NIN_A, DM}; pg8::StaticOrder S; S.init(M, NIN_A, G, bx);
        pg8::EpiQKV E{QKV, GT, 3, LF, IN(I_ABF), SSQ + (size_t)24 * M, (LAS float*)(L + XCH_OFF)};
#ifndef NO_EPIQKV_1
        pg8::gemm_phase<pg8::EpiQKV>(L, g, S, E);
#endif
    }
    {
        const int rr = ((M / 256) * (NIN_A / 256)) % G;
        int didx = -1, dstride = 1;
        if (rr == 0) { didx = bx * 8 + wave; dstride = G * 8; } else if (bx >= rr) { didx = (bx - rr) * 8 + wave; dstride = (G - rr) * 8; }
        if (didx >= 0) {
            int tid = threadIdx.x; asm volatile("" : "+v"(tid)); const int lane = tid & 63;
            LAS float* scr = (LAS float*)(L + wave * 16384);
            for (int it = didx; it < NDEF; it += dstride) {
                if (it < I3) transpose_item(IN(I_W2) + (size_t)FF * DM, FF, DM, DM, nullptr, W2T + (size_t)DM * FF, 0, scr, it, 64, lane);
                else transpose_item(IN(I_BWOUT), DM, DM, DM, nullptr, WOB, 0, scr, it - I3, 64, lane);
            }
        }
    }
    GRID_BAR();

    if (bx < BATCH * NH) {
        int tid = threadIdx.x; asm volatile("" : "+v"(tid)); const int lane = tid & 63;
        GAS float* p = LF + (size_t)bx * SEQ + tid * 8;
        f32x4 v0 = *(const GAS f32x4*)p, v1 = *(const GAS f32x4*)(p + 4);
        v0[1] += v0[0]; v0[2] += v0[1]; v0[3] += v0[2]; v1[0] += v0[3]; v1[1] += v1[0]; v1[2] += v1[1]; v1[3] += v1[2];
        const float tot = v1[3]; float x = tot;
#pragma unroll
        for (int o = 1; o < 64; o <<= 1) { const float t = __shfl_up(x, o); if (lane >= o) x += t; }
        LAS float* wt = (LAS float*)L;
        LAS float* cs = (LAS float*)(L + 256);
        if (lane == 63) wt[wave] = x;
        float gq = 0.f, gk = 0.f;
        if (tid < 64) { gq = fmaxf(fabsf(GT[tid]), fabsf(GT[tid + 64])); gk = fmaxf(fabsf(GT[HD + tid]), fabsf(GT[HD + tid + 64]));
#pragma unroll
            for (int o = 1; o < 64; o <<= 1) { gq = fmaxf(gq, __shfl_xor(gq, o)); gk = fmaxf(gk, __shfl_xor(gk, o)); }
            if (tid == 0) wt[8] = 2.f * 1.02f * RSC * gq * gk + 26.f; }
        __syncthreads();
        float off = x - tot;
        for (int w = 0; w < wave; ++w) off += wt[w];
        v0 = v0 + off; v1 = v1 + off;
        *(GAS f32x4*)p = v0; *(GAS f32x4*)(p + 4) = v1;
        *(LAS f32x4*)(cs + tid * 8) = v0; *(LAS f32x4*)(cs + tid * 8 + 4) = v1;
        __syncthreads();
        if (tid < 16) { const int P0 = tid * 256; const float cq = cs[P0], T = wt[8]; int t = 0;
            while (t < (P0 >> 6) && cq - cs[64 * t + 63] < -T) ++t;
            JT[bx * 16 + tid] = t; }
    }
    GRID_BAR();

#ifndef NO_ATT0
    att::attn_phase_dyn((char*)lds, (GAS unsigned*)a.ws + 3520, QKV, QKV + SEG, QKV + 2 * SEG, U, LF, JT);
#endif
#if PROBE_REPEAT == 3
    __syncthreads(); att::attn_phase<0>((char*)lds, vcu, G, QKV, QKV + SEG, QKV + 2 * SEG, U, LF, JT);
#endif
    GRID_BAR();

    {
        pg8::Gemm g{U, WOA, M, DM, DM}; pg8::StaticOrder S; S.init(M, DM, G, bx);
        pg8::EpiResid E{nullptr, U2, nullptr, U2, SSQ, (LAS float*)(L + XCH_OFF)};
#ifndef NO_EPIRESID_1
        pg8::gemm_phase<pg8::EpiResid>(L, g, S, E);
#endif
    }
    GRID_BAR();

#define MLP_BLOCK(layer, SSQ_IN, OUTF, HB_OUT, SSQ_OUT) do { \
        { pg8::Gemm g{U2, W1T + (size_t)(layer) * FF * DM, M, FF, DM}; pg8::StaticOrder S; S.init(M, FF, G, bx); \
          pg8::EpiRelu2 E{HID, SSQ_IN}; \
          pg8::gemm_phase<pg8::EpiRelu2>(L, g, S, E); \
          if (PROBE_REPEAT == 6 && (layer) == 0) { __syncthreads(); pg8::gemm_phase<pg8::EpiRelu2>(L, g, S, E); } } \
        GRID_BAR(); \
        { pg8::Gemm g{HID, W2T + (size_t)(layer) * DM * FF, M, DM, FF}; pg8::StaticOrder S; S.init(M, DM, G, bx); \
          pg8::EpiResid E{nullptr, U2, OUTF, HB_OUT, SSQ_OUT, (LAS float*)(L + XCH_OFF)}; \
          pg8::gemm_phase<pg8::EpiResid>(L, g, S, E); } } while (0)
    MLP_BLOCK(0, SSQ, (GAS float*)nullptr, U2, SSQ + (size_t)8 * M);
    GRID_BAR();
    {
        pg8::Gemm g{U2, WKVQ, M, NIN_B, DM}; pg8::StaticOrder S; S.init(M, NIN_B, G, bx);
        pg8::EpiQKV E{QKV, GT + 3 * HD, 5, nullptr, nullptr, SSQ + (size_t)8 * M, (LAS float*)(L + XCH_OFF)};
        pg8::gemm_phase<pg8::EpiQKV>(L, g, S, E);
    }
    GRID_BAR();
    att::attn_phase<1>((char*)lds, vcu, G, QKV + 2 * SEG, QKV, QKV + SEG, U, IN(I_BREL), JT);
#if PROBE_REPEAT == 10
    __syncthreads(); att::attn_phase<1>((char*)lds, vcu, G, QKV + 2 * SEG, QKV, QKV + SEG, U, IN(I_BREL), JT);
#endif
    GRID_BAR();
    {
        pg8::Gemm g{U, WOB, M, DM, DM}; pg8::StaticOrder S; S.init(M, DM, G, bx);
        pg8::EpiResid E{nullptr, U2, nullptr, U2, SSQ + (size_t)16 * M, (LAS float*)(L + XCH_OFF)};
        pg8::gemm_phase<pg8::EpiResid>(L, g, S, E);
    }
    GRID_BAR();
    MLP_BLOCK(1, SSQ + (size_t)16 * M, out, (GAS bf16_t*)nullptr, (GAS float*)nullptr);
#undef MLP_BLOCK
}

extern "C" void kernel_launch(void* const* d_in, const int* in_sizes, int n_in, void* d_out, int out_size, void* d_ws, size_t ws_size, hipStream_t stream) {
    static int grid = 0;
    if (grid == 0) {
        if (n_in != 18 || in_sizes[0] != M * DM || out_size != M * DM || ws_size < WS_END) {
            fprintf(stderr, "kernel_launch: shape mismatch (n_in %d in0 %d out %d ws %zu)\n", n_in, n_in > 0 ? in_sizes[0] : -1, out_size, ws_size); grid = -1; return; }
        int dev = 0, cus = 0, per_cu = 0;
        (void)hipGetDevice(&dev);
        if (hipDeviceGetAttribute(&cus, hipDeviceAttributeMultiprocessorCount, dev) != hipSuccess || cus <= 0) cus = 256;
        if (hipFuncSetAttribute((const void*)fwd_megakernel, hipFuncAttributeMaxDynamicSharedMemorySize, LDS_BYTES) != hipSuccess) { fprintf(stderr, "kernel_launch: hipFuncSetAttribute failed\n"); grid = -1; return; }
        if (hipOccupancyMaxActiveBlocksPerMultiprocessor(&per_cu, (const void*)fwd_megakernel, 512, LDS_BYTES) != hipSuccess || per_cu < 1) { fprintf(stderr, "kernel_launch: occupancy query says %d\n", per_cu); per_cu = 1; }
        (void)hipGetLastError();
        grid = cus * per_cu;
    }
    if (grid < 0) return;
    Args a{};
    for (int i = 0; i < 18; ++i) a.in[i] = (const float*)d_in[i];
    a.out = (float*)d_out; a.ws = (unsigned char*)d_ws;
    void* args[] = {&a};
    hipError_t e = hipLaunchCooperativeKernel((const void*)fwd_megakernel, dim3(grid), dim3(512), args, LDS_BYTES, stream);
    if (e != hipSuccess) fprintf(stderr, "kernel_launch: cooperative launch failed: %s (grid %d)\n", hipGetErrorString(e), grid);
}
```
